# Optimizing an MI355X kernel written in HIP

```python
import jax, jax.numpy as jnp
from jax import lax

D_MODEL = 1024
BATCH = 8
SEQ = 8192
DEPTH = 1

D_CONV = D_MODEL // 2
CONV_GROUPS = 8
CONV_WIDTH = 3
N_HEADS = 8
HEAD_DIM = 64
N_KV = 2
HPG = N_HEADS // N_KV
D_ATTN = N_HEADS * HEAD_DIM
D_MIX = D_CONV + D_ATTN
KV_DIM = N_KV * HEAD_DIM
CMP_LEN = 32
CMP_STRIDE = 16
CMP_HIDDEN = 2 * HEAD_DIM
SEL_LEN = 64
TOP_N = 16
WINDOW = 512
Q_BLOCK = 128
D_FF = -(-8 * D_MODEL // (3 * 256)) * 256
D_IN = 3 * D_CONV + D_ATTN + 6 * KV_DIM + 3 * N_HEADS
NEG = -1e30
FORCE = 1e9

kernel_name = "hybrid_conv_nsa_sandwich_adaln"


def rmsnorm(x, g, eps=1e-6):
    xf = x.astype(jnp.float32)
    y = xf * lax.rsqrt(jnp.mean(xf * xf, axis=-1, keepdims=True) + eps)
    return (y * g.astype(jnp.float32)).astype(x.dtype)


def alibi_slopes():
    h = jnp.arange(N_HEADS, dtype=jnp.float32) + 1.0
    return (2.0 ** (-8.0 * h / N_HEADS)).reshape(N_KV, HPG)


def short_conv_mixer(u, conv_w):
    b_gate, c_gate, v = jnp.split(u, 3, axis=-1)
    z = c_gate * v
    rhs = conv_w.astype(z.dtype)[:, None, :]
    zc = lax.conv_general_dilated(z, rhs, window_strides=(1,), padding=[(CONV_WIDTH - 1, 0)],
                                  dimension_numbers=("NWC", "WIO", "NWC"), feature_group_count=D_CONV)
    return b_gate * zc


def compress(kv, pos, w1, w2):
    B, S = kv.shape[:2]
    ch = kv.reshape(B, S // CMP_STRIDE, CMP_STRIDE, N_KV, HEAD_DIM)
    blk = jnp.concatenate([ch[:, :-1], ch[:, 1:]], axis=2) + pos.astype(kv.dtype)[None, None, :, None, :]
    h = jax.nn.gelu(jnp.einsum("bclgd,ldh->bcgh", blk, w1))
    return jnp.einsum("bcgh,hd->bcgd", h, w2)


def gather_blocks(blocks, idx):
    return jax.vmap(jax.vmap(lambda b_, i_: b_[i_]))(blocks, idx)


def nsa_mixer(q, k_cmp, v_cmp, k_sel, v_sel, k_win, v_win, gates, pos_cmp, w_ck1, w_ck2, w_cv1, w_cv2):
    B, S = q.shape[:2]
    f32 = jnp.float32
    kc = compress(k_cmp, pos_cmp, w_ck1, w_ck2)
    vc = compress(v_cmp, pos_cmp, w_cv1, w_cv2)
    NC = kc.shape[1]
    NS = S // SEL_LEN
    top_n = min(TOP_N, NS)
    ksb = k_sel.reshape(B, NS, SEL_LEN, N_KV, HEAD_DIM).transpose(0, 3, 1, 2, 4)
    vsb = v_sel.reshape(B, NS, SEL_LEN, N_KV, HEAD_DIM).transpose(0, 3, 1, 2, 4)
    pad = ((0, 0), (WINDOW, 0), (0, 0), (0, 0))
    kw_pad = jnp.pad(k_win, pad)
    vw_pad = jnp.pad(v_win, pad)
    sl = alibi_slopes()
    sl5 = sl[None, :, :, None, None]
    cmp_start = jnp.arange(NC) * CMP_STRIDE
    cmp_end = cmp_start + CMP_LEN - 1
    sel_start = jnp.arange(NS) * SEL_LEN
    overlap = ((cmp_start[:, None] < sel_start[None, :] + SEL_LEN) &
               (cmp_start[:, None] + CMP_LEN > sel_start[None, :])).astype(f32)
    scale = HEAD_DIM ** -0.5
    nq = S // Q_BLOCK
    qb = q.reshape(B, nq, Q_BLOCK, N_KV, HPG, HEAD_DIM).transpose(1, 0, 2, 3, 4, 5)
    gb = gates.reshape(B, nq, Q_BLOCK, N_KV, HPG, 3).transpose(1, 0, 2, 3, 4, 5)
    blk_ids = jnp.arange(NS)

    def block(args):
        q_c, g_c, q0 = args
        t = q0 + jnp.arange(Q_BLOCK)
        s = jnp.einsum("bqgnd,bkgd->bgnqk", q_c, kc, preferred_element_type=f32) * scale
        valid = cmp_end[None, :] <= t[:, None]
        dist = (t[:, None] - cmp_end[None, :]).astype(f32)
        s = jnp.where(valid, s - sl5 * dist, NEG)
        p = jax.nn.softmax(s, axis=-1) * jnp.any(valid, axis=-1)[:, None].astype(f32)
        o_cmp = jnp.einsum("bgnqk,bkgd->bqgnd", p.astype(vc.dtype), vc)
        imp = jnp.einsum("bgnqk,ks->bgqs", p, overlap)
        cur = t // SEL_LEN
        forced = (blk_ids[None, :] == 0) | (blk_ids[None, :] == cur[:, None]) | (blk_ids[None, :] == cur[:, None] - 1)
        causal_blk = sel_start[None, :] <= t[:, None]
        imp = jnp.where(causal_blk, jnp.where(forced, FORCE, imp), NEG)
        top_val, top_idx = lax.top_k(imp, top_n)
        kg = gather_blocks(ksb, top_idx)
        vg = gather_blocks(vsb, top_idx)
        kpos = top_idx[..., None] * SEL_LEN + jnp.arange(SEL_LEN)
        ok = (top_val > NEG / 2)[..., None] & (kpos <= t[:, None, None])
        s = jnp.einsum("bqgnd,bgqkld->bgnqkl", q_c, kg, preferred_element_type=f32) * scale
        dist = (t[:, None, None] - kpos).astype(f32)[:, :, None]
        s = jnp.where(ok[:, :, None], s - sl[None, :, :, None, None, None] * dist, NEG)
        p = jax.nn.softmax(s, axis=(-2, -1))
        o_sel = jnp.einsum("bgnqkl,bgqkld->bqgnd", p.astype(vg.dtype), vg)
        kw = lax.dynamic_slice_in_dim(kw_pad, q0, Q_BLOCK + WINDOW, axis=1)
        vw = lax.dynamic_slice_in_dim(vw_pad, q0, Q_BLOCK + WINDOW, axis=1)
        wpos = q0 - WINDOW + jnp.arange(Q_BLOCK + WINDOW)
        d = t[:, None] - wpos[None, :]
        okw = (d >= 0) & (d < WINDOW) & (wpos >= 0)[None, :]
        s = jnp.einsum("bqgnd,bkgd->bgnqk", q_c, kw, preferred_element_type=f32) * scale
        s = jnp.where(okw, s - sl5 * d.astype(f32), NEG)
        p = jax.nn.softmax(s, axis=-1)
        o_win = jnp.einsum("bgnqk,bkgd->bqgnd", p.astype(vw.dtype), vw)
        return g_c[..., 0:1] * o_cmp + g_c[..., 1:2] * o_sel + g_c[..., 2:3] * o_win

    out = lax.map(block, (qb, gb, jnp.arange(nq) * Q_BLOCK))
    return out.transpose(1, 0, 2, 3, 4, 5).reshape(B, S, N_KV, HPG, HEAD_DIM)


def setup_inputs(seed: int = 0) -> dict:
    key = jax.random.key(seed)
    ks = jax.random.split(key, 24)
    f32 = jnp.float32
    L = DEPTH

    def nrm(k, shape, s):
        return jax.random.normal(k, shape, f32) * s

    def gain(k, shape):
        return 1.0 + 0.02 * jax.random.normal(k, shape, f32)

    return {
        "x": nrm(ks[0], (BATCH, SEQ, D_MODEL), 1.0),
        "c": nrm(ks[1], (BATCH, D_MODEL), 1.0),
        "w_mod": nrm(ks[2], (L, D_MODEL, 6 * D_MODEL), 0.5 * D_MODEL ** -0.5),
        "b_mod": nrm(ks[3], (L, 6 * D_MODEL), 0.01),
        "g_pre_mix": gain(ks[4], (L, D_MODEL)),
        "w_in": nrm(ks[5], (L, D_MODEL, D_IN), D_MODEL ** -0.5),
        "conv_w": nrm(ks[6], (L, CONV_WIDTH, D_CONV), CONV_WIDTH ** -0.5),
        "pos_cmp": nrm(ks[7], (L, CMP_LEN, HEAD_DIM), 0.1),
        "w_ck1": nrm(ks[8], (L, CMP_LEN, HEAD_DIM, CMP_HIDDEN), (CMP_LEN * HEAD_DIM) ** -0.5),
        "w_ck2": nrm(ks[9], (L, CMP_HIDDEN, HEAD_DIM), CMP_HIDDEN ** -0.5),
        "w_cv1": nrm(ks[10], (L, CMP_LEN, HEAD_DIM, CMP_HIDDEN), (CMP_LEN * HEAD_DIM) ** -0.5),
        "w_cv2": nrm(ks[11], (L, CMP_HIDDEN, HEAD_DIM), CMP_HIDDEN ** -0.5),
        "g_conv_out": gain(ks[12], (L, D_CONV)),
        "g_attn_out": gain(ks[13], (L, D_ATTN)),
        "w_out": nrm(ks[14], (L, D_MIX, D_MODEL), D_MIX ** -0.5),
        "g_post_mix": gain(ks[15], (L, D_MODEL)),
        "g_pre_ffn": gain(ks[16], (L, D_MODEL)),
        "w_gate": nrm(ks[17], (L, D_MODEL, D_FF), D_MODEL ** -0.5),
        "w_up": nrm(ks[18], (L, D_MODEL, D_FF), D_MODEL ** -0.5),
        "w_down": nrm(ks[19], (L, D_FF, D_MODEL), D_FF ** -0.5),
        "g_post_ffn": gain(ks[20], (L, D_MODEL)),
    }


def reference(x, c, w_mod, b_mod, g_pre_mix, w_in, conv_w, pos_cmp, w_ck1, w_ck2, w_cv1, w_cv2,
              g_conv_out, g_attn_out, w_out, g_post_mix, g_pre_ffn, w_gate, w_up, w_down, g_post_ffn):
    B, S, _ = x.shape
    splits = [3 * D_CONV, 3 * D_CONV + D_ATTN, 3 * D_CONV + D_ATTN + 6 * KV_DIM]
    for l in range(DEPTH):
        mod = (jax.nn.silu(c) @ w_mod[l] + b_mod[l])[:, None, :]
        sh_m, sc_m, ga_m, sh_f, sc_f, ga_f = jnp.split(mod, 6, axis=-1)
        h = rmsnorm(x, g_pre_mix[l]) * (1.0 + sc_m) + sh_m
        u = h @ w_in[l]
        u_conv, q, kv, gl = jnp.split(u, splits, axis=-1)
        y_conv = rmsnorm(short_conv_mixer(u_conv, conv_w[l]), g_conv_out[l])
        q = q.reshape(B, S, N_KV, HPG, HEAD_DIM)
        k_cmp, v_cmp, k_sel, v_sel, k_win, v_win = [a.reshape(B, S, N_KV, HEAD_DIM) for a in jnp.split(kv, 6, axis=-1)]
        gates = jax.nn.sigmoid(gl.astype(jnp.float32)).astype(x.dtype).reshape(B, S, N_KV, HPG, 3)
        y_attn = nsa_mixer(q, k_cmp, v_cmp, k_sel, v_sel, k_win, v_win, gates,
                           pos_cmp[l], w_ck1[l], w_ck2[l], w_cv1[l], w_cv2[l])
        y_attn = rmsnorm(y_attn, g_attn_out[l].reshape(N_KV, HPG, HEAD_DIM)).reshape(B, S, D_ATTN)
        y = jnp.concatenate([y_conv, y_attn], axis=-1) @ w_out[l]
        x = x + ga_m * rmsnorm(y, g_post_mix[l])
        h = rmsnorm(x, g_pre_ffn[l]) * (1.0 + sc_f) + sh_f
        f = (jax.nn.silu(h @ w_gate[l]) * (h @ w_up[l])) @ w_down[l]
        x = x + ga_f * rmsnorm(f, g_post_ffn[l])
    return x
```

```cpp
#include <hip/hip_runtime.h>
#include <hip/hip_cooperative_groups.h>
#include <cstdio>
#include <cstdint>
namespace cg = cooperative_groups;
namespace pg8 {
#define PG8_LAS __attribute__((address_space(3)))
typedef unsigned short bf16_t;
typedef short bf16x8 __attribute__((ext_vector_type(8)));
typedef float f32x4 __attribute__((ext_vector_type(4)));
typedef unsigned u32x4 __attribute__((ext_vector_type(4)));
constexpr int BM = 256, BK = 64, HALF = 128, HTB = HALF * BK * 2  , STAGE_BYTES = 8 * HTB, NXCD = 8, WGM = 8;

__host__ __device__ __forceinline__ int lds_byte(int r, int c) { const int st = (r >> 4) * 2 + (c >> 5), rr = r & 15, cc = c & 31, ob = rr * 64 + cc * 2; return st * 1024 + (ob ^ (((ob >> 9) & 1) << 5)); }
__host__ __device__ __forceinline__ void stage_rc(int b, int& R, int& C) { const int st = b / 1024, sb = b % 1024, swz = sb ^ (((sb >> 9) & 1) << 5); R = (st >> 1) * 16 + swz / 64; C = (st & 1) * 32 + (swz % 64) / 2; }
__host__ __device__ __forceinline__ int perm32(int rho) { const int n = rho >> 4, i = rho & 15; return 8 * (i >> 2) + 4 * n + (i & 3); }

struct Unit { int pm, pn; };
struct Gemm { const bf16_t* A; const bf16_t* Bt; int M, N, K; };

struct StaticOrder {
    int nM, nN, nwg, G, c;
    __host__ __device__ void init(int M, int N, int G_, int c_) { nM = M / BM; nN = N / BM; nwg = nM * nN; G = G_; c = c_; }
    __host__ __device__ bool next(int i, Unit& u) const {
        const long L = (long)i * G + c; if (L >= nwg) return false;
        int wgid = (int)L; { const int q = nwg / NXCD, r = nwg % NXCD, xcd = wgid % NXCD, off = wgid / NXCD; wgid = (xcd < r ? xcd * (q + 1) : r * (q + 1) + (xcd - r) * q) + off; }
        const int nig = WGM * nN, gid = wgid / nig, fm = gid * WGM, gsz = (nM - fm) < WGM ? (nM - fm) : WGM;
        u.pm = fm + ((wgid % nig) % gsz); u.pn = (wgid % nig) / gsz; return true;
    }
    __device__ __forceinline__ void a_ready(const Unit&) const {}
    __device__ __forceinline__ void done(const Unit&) const {}
};

__device__ __forceinline__ unsigned cvt_pk_bf16(float lo, float hi) { unsigned r; asm volatile("v_cvt_pk_bf16_f32 %0, %1, %2" : "=v"(r) : "v"(lo), "v"(hi)); return r; }
typedef float f32x2 __attribute__((ext_vector_type(2)));
__device__ __forceinline__ int fresh_lane() { int l; asm volatile("v_mbcnt_lo_u32_b32 %0, -1, 0\n\tv_mbcnt_hi_u32_b32 %0, -1, %0" : "=v"(l)); return l; }
typedef unsigned u32x2 __attribute__((ext_vector_type(2)));
__device__ __forceinline__ u32x4 pack8(const f32x4& v0, const f32x4& v1) { u32x4 w; w.x = cvt_pk_bf16(v0[0], v0[1]); w.y = cvt_pk_bf16(v0[2], v0[3]); w.z = cvt_pk_bf16(v1[0], v1[1]); w.w = cvt_pk_bf16(v1[2], v1[3]); return w; }
struct EpiPlain {
    static constexpr bool PERM = true, AFTER_DRAIN = false;
    bf16_t* O; int ldc;
    __device__ __forceinline__ void operator()(const f32x4 (&acc)[2][2][4][2], const Unit& u, int wr, int wc, int fr, int fq) const {
        const int row0 = u.pm * BM + wr * 64 + fr, col0 = u.pn * BM + wc * 32 + 8 * fq;
#pragma unroll
        for (int ai = 0; ai < 2; ++ai)
#pragma unroll
            for (int m = 0; m < 4; ++m) { bf16_t* rowp = O + (size_t)(row0 + ai * HALF + m * 16) * ldc + col0;
#pragma unroll
                for (int bj = 0; bj < 2; ++bj) *(u32x4*)(rowp + bj * HALF) = pack8(acc[ai][bj][m][0], acc[ai][bj][m][1]); }
    }
};
struct EpiRow {
    static constexpr bool PERM = true, AFTER_DRAIN = false;
    bf16_t* O; float* RSS;
    __device__ __forceinline__ void operator()(const f32x4 (&acc)[2][2][4][2], const Unit& u, int wr, int wc, int fr, int fq) const {
        const int row0 = u.pm * BM + wr * 64 + fr, col0 = u.pn * BM + wc * 32 + 8 * fq;
#pragma unroll
        for (int ai = 0; ai < 2; ++ai)
#pragma unroll
            for (int m = 0; m < 4; ++m) { const int row = row0 + ai * HALF + m * 16; bf16_t* rowp = O + (size_t)row * 1024 + col0; float s = 0.f;
#pragma unroll
                for (int bj = 0; bj < 2; ++bj) { const f32x4 v0 = acc[ai][bj][m][0], v1 = acc[ai][bj][m][1];
                    s += (v0[0] * v0[0] + v0[1] * v0[1]) + (v0[2] * v0[2] + v0[3] * v0[3]) + (v1[0] * v1[0] + v1[1] * v1[1]) + (v1[2] * v1[2] + v1[3] * v1[3]);
                    *(u32x4*)(rowp + bj * HALF) = pack8(v0, v1); }
                s += __shfl_xor(s, 16); s += __shfl_xor(s, 32);
                if (fq == 0) RSS[(size_t)row * 16 + u.pn * 4 + wc] = s; }
    }
};
struct EpiGU {
    static constexpr bool PERM = true, AFTER_DRAIN = false;
    bf16_t* O;
    __device__ __forceinline__ void operator()(const f32x4 (&acc)[2][2][4][2], const Unit& u, int wr, int wc, int fr, int fq) const {
        const int row0 = u.pm * BM + wr * 64 + fr, col0 = (u.pn * BM + wc * 32 + 8 * fq) >> 1;
#pragma unroll
        for (int ai = 0; ai < 2; ++ai)
#pragma unroll
            for (int m = 0; m < 4; ++m) { bf16_t* rowp = O + (size_t)(row0 + ai * HALF + m * 16) * 2816 + col0;
#pragma unroll
                for (int bj = 0; bj < 2; ++bj) { const f32x4 g = acc[ai][bj][m][0], up = acc[ai][bj][m][1]; float a[4];
#pragma unroll
                    for (int i = 0; i < 4; ++i) a[i] = g[i] * __builtin_amdgcn_rcpf(1.f + __builtin_amdgcn_exp2f(-1.44269504f * g[i])) * up[i];
                    u32x2 w; w.x = cvt_pk_bf16(a[0], a[1]); w.y = cvt_pk_bf16(a[2], a[3]); *(u32x2*)(rowp + bj * (HALF / 2)) = w; } }
    }
};
struct EpiIn {
    static constexpr bool PERM = true, AFTER_DRAIN = false;
    bf16_t *U, *KC, *KS, *KW, *VST, *VWT; float* GATES;
    __device__ __forceinline__ void operator()(const f32x4 (&acc)[2][2][4][2], const Unit& u, int wr, int wc, int fr, int fq) const {
        const int row0 = u.pm * BM + wr * 64 + fr, pn = u.pn, c128 = wc * 32 + 8 * fq, g = c128 >> 6, d = c128 & 63;
#pragma unroll
        for (int ai = 0; ai < 2; ++ai)
#pragma unroll
            for (int m = 0; m < 4; ++m) { const int row = row0 + ai * HALF + m * 16, b = row >> 13, s = row & 8191;
#pragma unroll
                for (int bj = 0; bj < 2; ++bj) { const f32x4 v0 = acc[ai][bj][m][0], v1 = acc[ai][bj][m][1];
                    if (pn < 8) { *(u32x4*)(U + (size_t)row * 2048 + pn * BM + bj * HALF + c128) = pack8(v0, v1); }
                    else if (pn == 8) { *(u32x4*)(KC + ((size_t)((bj * 8 + b) * 2 + g) * 8192 + s) * 64 + d) = pack8(v0, v1); }
                    else if (pn <= 10) {
                        if (bj == 0) { bf16_t* K = (pn == 9) ? KS : KW; *(u32x4*)(K + ((size_t)(b * 2 + g) * 8192 + s) * 64 + d) = pack8(v0, v1); }
                        else { bf16_t* V = ((pn == 9) ? VST : VWT) + ((size_t)(b * 2 + g) * 64 + d) * 8192 + s; const u32x4 w = pack8(v0, v1);
                            V[0 * 8192] = (bf16_t)(w.x & 0xffffu); V[1 * 8192] = (bf16_t)(w.x >> 16); V[2 * 8192] = (bf16_t)(w.y & 0xffffu); V[3 * 8192] = (bf16_t)(w.y >> 16);
                            V[4 * 8192] = (bf16_t)(w.z & 0xffffu); V[5 * 8192] = (bf16_t)(w.z >> 16); V[6 * 8192] = (bf16_t)(w.w & 0xffffu); V[7 * 8192] = (bf16_t)(w.w >> 16); }
                    } else if (bj == 0 && c128 < 24) { f32x4 s0, s1;
#pragma unroll
                        for (int i = 0; i < 4; ++i) { s0[i] = __builtin_amdgcn_rcpf(1.f + __builtin_amdgcn_exp2f(-1.44269504f * v0[i])); s1[i] = __builtin_amdgcn_rcpf(1.f + __builtin_amdgcn_exp2f(-1.44269504f * v1[i])); }
                        *(f32x4*)(GATES + (size_t)row * 24 + c128) = s0; *(f32x4*)(GATES + (size_t)row * 24 + c128 + 4) = s1; }
                } }
    }
};
template <class Epi, class Sched, bool ALIGN_EPI = false, bool SP2 = false>
__device__ __forceinline__ void gemm_phase(PG8_LAS unsigned char* lds, const Gemm g, const Sched& S, const Epi& E) {
    const int wid = __builtin_amdgcn_readfirstlane(threadIdx.x >> 6), lane = fresh_lane(), tid = wid * 64 + lane, wr = wid >> 2, wc = wid & 3, fr = lane & 15, fq = lane >> 4;
    const int K = g.K, nt = K / BK;
    unsigned voffA[2], voffB[2];
#pragma unroll
    for (int i = 0; i < 2; ++i) { int R, C; stage_rc(tid * 16 + i * 8192, R, C); const int Rb = Epi::PERM ? ((R & ~31) + perm32(R & 31)) : R;
        voffA[i] = (unsigned)(R * K + C) * 2u; voffB[i] = (unsigned)(Rb * K + C) * 2u; }
    const size_t kstep = (size_t)(BK * 2);
    const size_t hstep = (size_t)HALF * K * 2;
    const size_t tstep = 2 * hstep;
    const unsigned ldsw = (unsigned)wid * 1024u;
    const int aoff = lds_byte(wr * 64 + fr, fq * 8), boff = lds_byte(wc * 32 + fr, fq * 8);
#define PG8_SA(b, h) (((b) * 2 + (h)) * HTB)
#define PG8_SB(b, h) ((4 + (b) * 2 + (h)) * HTB)
#define PG8_STAGE(bufoff, gbase, voff) do { _Pragma("unroll") for (int _i = 0; _i < 2; ++_i) \
        __builtin_amdgcn_global_load_lds((const unsigned*)((const char*)(gbase) + (voff)[_i]), (PG8_LAS unsigned*)(lds + (bufoff) + ldsw + _i * 8192), 16, 0, 0); } while (0)
#define PG8_LDA(dst, b, h) do { _Pragma("unroll") for (int m = 0; m < 4; ++m) _Pragma("unroll") for (int k = 0; k < 2; ++k) dst[m][k] = *(const PG8_LAS bf16x8*)(lds + PG8_SA(b, h) + aoff + m * 2048 + k * 1024); } while (0)
#define PG8_LDB(dst, b, h) do { _Pragma("unroll") for (int n = 0; n < 2; ++n) _Pragma("unroll") for (int k = 0; k < 2; ++k) dst[n][k] = *(const PG8_LAS bf16x8*)(lds + PG8_SB(b, h) + boff + n * 2048 + k * 1024); } while (0)
#define PG8_MMA(ai, bj, At, Bt) do { __builtin_amdgcn_s_setprio(1); _Pragma("unroll") for (int m = 0; m < 4; ++m) _Pragma("unroll") for (int n = 0; n < 2; ++n) _Pragma("unroll") for (int k = 0; k < 2; ++k) \
        acc[ai][bj][m][n] = __builtin_amdgcn_mfma_f32_16x16x32_bf16(Bt[n][k], At[m][k], acc[ai][bj][m][n], 0, 0, 0); __builtin_amdgcn_s_setprio(0); } while (0)
#define PG8_WAIT_V(n) asm volatile("s_waitcnt vmcnt(" #n ")" ::: "memory")
#define PG8_WAIT_L(n) asm volatile("s_waitcnt lgkmcnt(" #n ")" ::: "memory")
#define PG8_BAR __builtin_amdgcn_s_barrier()
#define PG8_SCHED __builtin_amdgcn_sched_barrier(0)
    Unit cur, nxt; int ui = 0;
    if (!S.next(0, cur)) return;
    f32x4 acc[2][2][4][2];
#pragma unroll
    for (int a = 0; a < 2; ++a)
#pragma unroll
        for (int b = 0; b < 2; ++b)
#pragma unroll
            for (int m = 0; m < 4; ++m)
#pragma unroll
                for (int n = 0; n < 2; ++n) acc[a][b][m][n] = (f32x4){0.f, 0.f, 0.f, 0.f};
    bf16x8 At[4][2], B0[2][2], B1[2][2];
    const char* cA = (const char*)g.A + (size_t)cur.pm * tstep; const char* cB = (const char*)g.Bt + (size_t)cur.pn * tstep;
    S.a_ready(cur);
    if constexpr (SP2) {
        PG8_STAGE(PG8_SB(0, 0), cB, voffB); PG8_STAGE(PG8_SB(0, 1), cB + hstep, voffB); PG8_STAGE(PG8_SA(0, 0), cA, voffA); PG8_STAGE(PG8_SA(0, 1), cA + hstep, voffA);
        if (wr == 1) PG8_BAR;
        PG8_WAIT_V(2); PG8_BAR;
        PG8_STAGE(PG8_SB(1, 0), cB + kstep, voffB); PG8_STAGE(PG8_SA(1, 0), cA + kstep, voffA); PG8_STAGE(PG8_SB(1, 1), cB + hstep + kstep, voffB);
        PG8_WAIT_V(6); PG8_BAR;
    } else {
        PG8_STAGE(PG8_SB(0, 0), cB, voffB); PG8_STAGE(PG8_SA(0, 0), cA, voffA); PG8_STAGE(PG8_SB(0, 1), cB + hstep, voffB); PG8_STAGE(PG8_SA(0, 1), cA + hstep, voffA);
        if (wr == 1) PG8_BAR;
        PG8_WAIT_V(4); PG8_BAR;
        PG8_STAGE(PG8_SB(1, 0), cB + kstep, voffB); PG8_STAGE(PG8_SA(1, 0), cA + kstep, voffA); PG8_STAGE(PG8_SB(1, 1), cB + hstep + kstep, voffB);
        PG8_WAIT_V(6); PG8_BAR;
    }
    for (;;) {
        const bool has_next = S.next(ui + 1, nxt);
        const char* nA = has_next ? (const char*)g.A + (size_t)nxt.pm * tstep : cA; const char* nB = has_next ? (const char*)g.Bt + (size_t)nxt.pn * tstep : cB;
        for (int t = 0; t < nt; t += 2) {
            const bool last = (t == nt - 2);
            const char* a1 = cA + (size_t)(t + 1) * kstep;
            const char* a2 = last ? nA : cA + (size_t)(t + 2) * kstep; const char* b2 = last ? nB : cB + (size_t)(t + 2) * kstep;
            const char* a3 = a2 + kstep; const char* b3 = b2 + kstep;
            if (last && has_next) S.a_ready(nxt);
            if constexpr (SP2) {
            PG8_LDB(B0, 0, 0); PG8_LDB(B1, 0, 1); PG8_SCHED; PG8_LDA(At, 0, 0); PG8_STAGE(PG8_SA(1, 1), a1 + hstep, voffA);
            PG8_WAIT_V(8); PG8_WAIT_L(0); PG8_BAR; PG8_MMA(0, 0, At, B0); PG8_MMA(0, 1, At, B1); PG8_BAR; PG8_SCHED;
            PG8_LDA(At, 0, 1); PG8_STAGE(PG8_SB(0, 0), b2, voffB); PG8_STAGE(PG8_SB(0, 1), b2 + hstep, voffB); PG8_STAGE(PG8_SA(0, 0), a2, voffA);
            PG8_WAIT_V(8); PG8_WAIT_L(0); PG8_BAR; PG8_MMA(1, 0, At, B0); PG8_MMA(1, 1, At, B1); PG8_BAR; PG8_SCHED;
            PG8_LDB(B0, 1, 0); PG8_LDB(B1, 1, 1); PG8_SCHED; PG8_LDA(At, 1, 0); PG8_STAGE(PG8_SA(0, 1), a2 + hstep, voffA);
            PG8_WAIT_V(8); PG8_WAIT_L(0); PG8_BAR; PG8_MMA(0, 0, At, B0); PG8_MMA(0, 1, At, B1); PG8_BAR; PG8_SCHED;
            PG8_LDA(At, 1, 1); PG8_STAGE(PG8_SB(1, 0), b3, voffB); PG8_STAGE(PG8_SB(1, 1), b3 + hstep, voffB); PG8_STAGE(PG8_SA(1, 0), a3, voffA);
            PG8_WAIT_V(8); PG8_WAIT_L(0); PG8_BAR; PG8_MMA(1, 0, At, B0); PG8_MMA(1, 1, At, B1); PG8_BAR; PG8_SCHED;
            } else {
            PG8_LDB(B0, 0, 0); PG8_SCHED; PG8_LDA(At, 0, 0); PG8_STAGE(PG8_SA(1, 1), a1 + hstep, voffA);
            PG8_WAIT_L(8); PG8_BAR; PG8_WAIT_L(0); PG8_MMA(0, 0, At, B0); PG8_BAR; PG8_SCHED;
            PG8_LDB(B1, 0, 1); PG8_STAGE(PG8_SB(0, 0), b2, voffB);
            PG8_BAR; PG8_WAIT_L(0); PG8_MMA(0, 1, At, B1); PG8_BAR;
            PG8_LDA(At, 0, 1); PG8_STAGE(PG8_SA(0, 0), a2, voffA);
            PG8_BAR; PG8_WAIT_L(0); PG8_MMA(1, 0, At, B0); PG8_BAR; PG8_SCHED;
            PG8_STAGE(PG8_SB(0, 1), b2 + hstep, voffB);
            PG8_WAIT_V(6); PG8_BAR; PG8_MMA(1, 1, At, B1); PG8_BAR;
            PG8_LDB(B0, 1, 0); PG8_SCHED; PG8_LDA(At, 1, 0); PG8_STAGE(PG8_SA(0, 1), a2 + hstep, voffA);
            PG8_WAIT_L(8); PG8_BAR; PG8_WAIT_L(0); PG8_MMA(0, 0, At, B0); PG8_BAR; PG8_SCHED;
            PG8_LDB(B1, 1, 1); PG8_STAGE(PG8_SB(1, 0), b3, voffB);
            PG8_BAR; PG8_WAIT_L(0); PG8_MMA(0, 1, At, B1); PG8_BAR;
            PG8_LDA(At, 1, 1); PG8_STAGE(PG8_SA(1, 0), a3, voffA);
            PG8_BAR; PG8_WAIT_L(0); PG8_MMA(1, 0, At, B0); PG8_BAR; PG8_SCHED;
            PG8_STAGE(PG8_SB(1, 1), b3 + hstep, voffB);
            PG8_WAIT_V(6); PG8_BAR; PG8_MMA(1, 1, At, B1); PG8_BAR;
            }
        }
        if constexpr (ALIGN_EPI) { if (wr == 0) PG8_BAR; }
        if constexpr (!Epi::AFTER_DRAIN) { E(acc, cur, wr, wc, fr, fq); S.done(cur); }
        if (!has_next) break;
#pragma unroll
        for (int a = 0; a < 2; ++a)
#pragma unroll
            for (int b = 0; b < 2; ++b)
#pragma unroll
                for (int m = 0; m < 4; ++m)
#pragma unroll
                    for (int n = 0; n < 2; ++n) acc[a][b][m][n] = (f32x4){0.f, 0.f, 0.f, 0.f};
        cur = nxt; cA = nA; cB = nB; ++ui;
        if constexpr (ALIGN_EPI) { if (wr == 1) PG8_BAR; }
    }
    PG8_WAIT_V(0);
    if constexpr (!ALIGN_EPI) { if (wr == 0) PG8_BAR; }
    PG8_BAR;
    if constexpr (Epi::AFTER_DRAIN) { E.fused(acc, cur, wr, wc, fr, fq, lds, wid, lane); S.done(cur); }
#undef PG8_SA
#undef PG8_SB
#undef PG8_STAGE
#undef PG8_LDA
#undef PG8_LDB
#undef PG8_MMA
#undef PG8_WAIT_V
#undef PG8_WAIT_L
#undef PG8_BAR
#undef PG8_SCHED
}
}

typedef unsigned short bf16;
typedef float f32x4 __attribute__((ext_vector_type(4)));
typedef short bf16x8 __attribute__((ext_vector_type(8)));
typedef unsigned u32x4 __attribute__((ext_vector_type(4)));
typedef unsigned u32x2 __attribute__((ext_vector_type(2)));
constexpr int NB = 8, SEQ = 8192, DM = 1024, MTOK = NB * SEQ, DIN = 2840, NINP = 3072, DFF = 2816;
constexpr int NWAVES = 8, NTHREADS = 512;
constexpr int LDS_BYTES = 147456;
constexpr size_t MiB = 1u << 20;
constexpr size_t WS_WIN = 0, WS_WOUT = 6 * MiB, WS_WGU = 8 * MiB, WS_WDN = 19 * MiB, WS_W1K = 25 * MiB, WS_W1V = WS_W1K + MiB / 2;
constexpr size_t WS_MODP = 26 * MiB;
constexpr size_t WS_CBP = 28 * MiB;
constexpr size_t WS_KCC = 29 * MiB, WS_VCT = 30 * MiB;
constexpr size_t WS_RSS1 = 32 * MiB, WS_RSS2 = 36 * MiB;
constexpr size_t WS_HC = 40 * MiB;
constexpr size_t WS_GATES = 48 * MiB;
constexpr size_t WS_H = 64 * MiB;
constexpr size_t WS_U = 192 * MiB;
constexpr size_t WS_KC = WS_U + 256 * MiB;
constexpr size_t WS_KS = WS_KC + 32 * MiB, WS_KW = WS_KS + 16 * MiB, WS_VST = WS_KW + 16 * MiB, WS_VWT = WS_VST + 16 * MiB;
constexpr size_t WS_ACT = WS_U;
constexpr size_t WS_YCAT = WS_U + 352 * MiB;
constexpr size_t WS_Y = WS_YCAT + 128 * MiB;
constexpr size_t WS_FSCR = WS_Y + 128 * MiB;
constexpr size_t WS_END = WS_FSCR + 32 * MiB;

struct Params {
    const float *x, *c, *w_mod, *b_mod, *g_pre_mix, *w_in, *conv_w, *pos_cmp, *w_ck1, *w_ck2, *w_cv1, *w_cv2, *g_conv_out, *g_attn_out, *w_out, *g_post_mix, *g_pre_ffn, *w_gate, *w_up, *w_down, *g_post_ffn;
    float* out; unsigned char* ws;
};

__device__ __forceinline__ unsigned cvtpk(float lo, float hi) { unsigned r; asm volatile("v_cvt_pk_bf16_f32 %0, %1, %2" : "=v"(r) : "v"(lo), "v"(hi)); return r; }
__device__ __forceinline__ float bflo(unsigned w) { return __uint_as_float(w << 16); }
__device__ __forceinline__ float bfhi(unsigned w) { return __uint_as_float(w & 0xffff0000u); }
__device__ __forceinline__ float wave_sum(float v) {
#pragma unroll
    for (int o = 1; o < 64; o <<= 1) v += __shfl_xor(v, o);
    return v;
}
#define LDS_WAIT() asm volatile("s_waitcnt lgkmcnt(0)" ::: "memory")

template <int MAP> __device__ __forceinline__ int rowmap(int n) { return MAP == 0 ? n : (MAP == 1 ? 8 * (n >> 2) + (n & 3) : 8 * (n >> 2) + 4 + (n & 3)); }
template <int MAP> __device__ __forceinline__ void p0_transpose_item(const float* W, int K, int N, bf16* WT, int row_off, float* scr, int item, int lane) {
    const int nblk = (N + 31) / 32, kb = item / nblk, nb = item % nblk, k0 = 64 * kb, n0 = 32 * nb;
    const int nn = n0 + (lane & 31);
#pragma unroll 8
    for (int i = 0; i < 32; ++i) { const int kk = 2 * i + (lane >> 5); scr[kk * 33 + (lane & 31)] = nn < N ? W[(size_t)(k0 + kk) * N + nn] : 0.f; }
    LDS_WAIT();
    const int c = lane & 7;
#pragma unroll
    for (int j = 0; j < 4; ++j) { const int n = (lane >> 3) + 8 * j; const float* s = scr + (8 * c) * 33 + n;
        u32x4 o; o.x = cvtpk(s[0 * 33], s[1 * 33]); o.y = cvtpk(s[2 * 33], s[3 * 33]); o.z = cvtpk(s[4 * 33], s[5 * 33]); o.w = cvtpk(s[6 * 33], s[7 * 33]);
        if (n0 + n < N) *(u32x4*)(WT + (size_t)(row_off + rowmap<MAP>(n0 + n)) * K + k0 + 8 * c) = o; }
    LDS_WAIT();
}

__device__ __forceinline__ void phase0(const Params& p, unsigned char* lds, int gw, int NGW, int wave, int lane) {
    unsigned char* ws = p.ws;
    float* scr = (float*)(lds + wave * 16384);
    constexpr int I_IN = 16 * 89, I_OUT = 16 * 32, I_G = 16 * 88, I_DN = 44 * 32, I_C1 = 16 * 4;
    constexpr int NT = I_IN + I_OUT + 2 * I_G + I_DN + 4 * I_C1;
    constexpr int I_MOD = 96 * 8, I_CB = 2 * 16;
    for (int it = gw; it < NT + I_MOD + I_CB; it += NGW) {
        int r = it;
        if (r < I_IN) { p0_transpose_item<0>(p.w_in, 1024, DIN, (bf16*)(ws + WS_WIN), 0, scr, r, lane); continue; } r -= I_IN;
        if (r < I_OUT) { p0_transpose_item<0>(p.w_out, 1024, 1024, (bf16*)(ws + WS_WOUT), 0, scr, r, lane); continue; } r -= I_OUT;
        if (r < I_G) { p0_transpose_item<1>(p.w_gate, 1024, DFF, (bf16*)(ws + WS_WGU), 0, scr, r, lane); continue; } r -= I_G;
        if (r < I_G) { p0_transpose_item<2>(p.w_up, 1024, DFF, (bf16*)(ws + WS_WGU), 0, scr, r, lane); continue; } r -= I_G;
        if (r < I_DN) { p0_transpose_item<0>(p.w_down, DFF, 1024, (bf16*)(ws + WS_WDN), 0, scr, r, lane); continue; } r -= I_DN;
        if (r < I_C1) { p0_transpose_item<0>(p.w_ck1, 1024, 128, (bf16*)(ws + WS_W1K), 0, scr, r, lane); continue; } r -= I_C1;
        if (r < I_C1) { p0_transpose_item<0>(p.w_ck1 + 1024 * 128, 1024, 128, (bf16*)(ws + WS_W1K), 128, scr, r, lane); continue; } r -= I_C1;
        if (r < I_C1) { p0_transpose_item<0>(p.w_cv1, 1024, 128, (bf16*)(ws + WS_W1V), 0, scr, r, lane); continue; } r -= I_C1;
        if (r < I_C1) { p0_transpose_item<0>(p.w_cv1 + 1024 * 128, 1024, 128, (bf16*)(ws + WS_W1V), 128, scr, r, lane); continue; } r -= I_C1;
        if (r < I_MOD) {
            const int cb = r >> 3, kc = r & 7, n = cb * 64 + lane; float a[8];
#pragma unroll
            for (int b = 0; b < 8; ++b) a[b] = 0.f;
            for (int k = kc * 128; k < kc * 128 + 128; ++k) { const float w = p.w_mod[(size_t)k * 6144 + n];
#pragma unroll
                for (int b = 0; b < 8; ++b) { const float cv = p.c[b * 1024 + k]; a[b] += cv * __builtin_amdgcn_rcpf(1.f + __builtin_amdgcn_exp2f(-1.44269504f * cv)) * w; } }
            float* MODP = (float*)(ws + WS_MODP);
#pragma unroll
            for (int b = 0; b < 8; ++b) MODP[(size_t)(kc * 8 + b) * 6144 + n] = a[b];
            continue; }
        r -= I_MOD;
        {
            const int kv = r >> 4, kc = r & 15; const float* w1 = kv ? p.w_cv1 : p.w_ck1; float a0 = 0.f, a1 = 0.f;
            for (int k = kc * 128; k < kc * 128 + 128; ++k) { const float pv = p.pos_cmp[k]; a0 += pv * w1[(size_t)k * 128 + lane]; a1 += pv * w1[(size_t)k * 128 + 64 + lane]; }
            float* CBP = (float*)(ws + WS_CBP);
            CBP[(kv * 16 + kc) * 128 + lane] = a0; CBP[(kv * 16 + kc) * 128 + 64 + lane] = a1; }
    }
}

__device__ __forceinline__ float mod_val(const Params& p, int b, int col) {
    const float* MODP = (const float*)(p.ws + WS_MODP); float s = p.b_mod[col];
#pragma unroll
    for (int kc = 0; kc < 8; ++kc) s += MODP[(size_t)(kc * 8 + b) * 6144 + col];
    return s;
}
__device__ __forceinline__ void phase_norm1(const Params& p, unsigned char* lds, int tid, int wave, int lane) {
    float* A = (float*)lds; float* Bv = A + 1024;
    for (int chunk = blockIdx.x; chunk < 256; chunk += gridDim.x) {
        const int b = chunk >> 5;
        __syncthreads();
        for (int col = tid; col < 1024; col += NTHREADS) { A[col] = p.g_pre_mix[col] * (1.f + mod_val(p, b, 1024 + col)); Bv[col] = mod_val(p, b, col); }
        __syncthreads();
        for (int r = wave; r < 256; r += NWAVES) { const size_t row = (size_t)chunk * 256 + r;
            const f32x4* xr = (const f32x4*)(p.x + row * 1024) + lane; f32x4 v[4]; float s = 0.f;
#pragma unroll
            for (int j = 0; j < 4; ++j) { v[j] = xr[64 * j]; s += (v[j][0] * v[j][0] + v[j][1] * v[j][1]) + (v[j][2] * v[j][2] + v[j][3] * v[j][3]); }
            const float rs = rsqrtf(wave_sum(s) * (1.f / 1024.f) + 1e-6f);
            u32x2* o = (u32x2*)((bf16*)(p.ws + WS_H) + row * 1024) + lane;
#pragma unroll
            for (int j = 0; j < 4; ++j) { const f32x4 a = ((const f32x4*)A)[64 * j + lane], bb = ((const f32x4*)Bv)[64 * j + lane]; const f32x4 h = v[j] * rs * a + bb;
                u32x2 w; w.x = cvtpk(h[0], h[1]); w.y = cvtpk(h[2], h[3]); o[64 * j] = w; } }
    }
}
__device__ __forceinline__ void phase_mid(const Params& p, unsigned char* lds, int tid, int wave, int lane) {
    float* A1 = (float*)lds; float* A2 = A1 + 1024; float* A3 = A2 + 1024;
    const float* RSS = (const float*)(p.ws + WS_RSS1);
    for (int chunk = blockIdx.x; chunk < 256; chunk += gridDim.x) {
        const int b = chunk >> 5;
        __syncthreads();
        for (int col = tid; col < 1024; col += NTHREADS) { A1[col] = mod_val(p, b, 2048 + col) * p.g_post_mix[col]; A2[col] = p.g_pre_ffn[col] * (1.f + mod_val(p, b, 4096 + col)); A3[col] = mod_val(p, b, 3072 + col); }
        __syncthreads();
        for (int r = wave; r < 256; r += NWAVES) { const size_t row = (size_t)chunk * 256 + r;
            float ss = RSS[row * 16 + (lane & 15)]; ss += __shfl_xor(ss, 1); ss += __shfl_xor(ss, 2); ss += __shfl_xor(ss, 4); ss += __shfl_xor(ss, 8);
            const float r1 = rsqrtf(ss * (1.f / 1024.f) + 1e-6f);
            const f32x4* xr = (const f32x4*)(p.x + row * 1024) + lane; const u32x2* yr = (const u32x2*)((const bf16*)(p.ws + WS_Y) + row * 1024) + lane;
            f32x4* orow = (f32x4*)(p.out + row * 1024) + lane; f32x4 v[4]; float s = 0.f;
#pragma unroll
            for (int j = 0; j < 4; ++j) { const u32x2 yw = yr[64 * j]; const f32x4 y = {bflo(yw.x), bfhi(yw.x), bflo(yw.y), bfhi(yw.y)}; const f32x4 a1 = ((const f32x4*)A1)[64 * j + lane];
                v[j] = xr[64 * j] + a1 * y * r1; orow[64 * j] = v[j]; s += (v[j][0] * v[j][0] + v[j][1] * v[j][1]) + (v[j][2] * v[j][2] + v[j][3] * v[j][3]); }
            const float r2 = rsqrtf(wave_sum(s) * (1.f / 1024.f) + 1e-6f);
            u32x2* o = (u32x2*)((bf16*)(p.ws + WS_H) + row * 1024) + lane;
#pragma unroll
            for (int j = 0; j < 4; ++j) { const f32x4 a = ((const f32x4*)A2)[64 * j + lane], bb = ((const f32x4*)A3)[64 * j + lane]; const f32x4 h = v[j] * r2 * a + bb;
                u32x2 w; w.x = cvtpk(h[0], h[1]); w.y = cvtpk(h[2], h[3]); o[64 * j] = w; } }
    }
}
__device__ __forceinline__ void phase_final(const Params& p, unsigned char* lds, int tid, int wave, int lane) {
    float* A1 = (float*)lds;
    const float* RSS = (const float*)(p.ws + WS_RSS2);
    for (int chunk = blockIdx.x; chunk < 256; chunk += gridDim.x) {
        const int b = chunk >> 5;
        __syncthreads();
        for (int col = tid; col < 1024; col += NTHREADS) A1[col] = mod_val(p, b, 5120 + col) * p.g_post_ffn[col];
        __syncthreads();
        for (int r = wave; r < 256; r += NWAVES) { const size_t row = (size_t)chunk * 256 + r;
            float ss = RSS[row * 16 + (lane & 15)]; ss += __shfl_xor(ss, 1); ss += __shfl_xor(ss, 2); ss += __shfl_xor(ss, 4); ss += __shfl_xor(ss, 8);
            const float r1 = rsqrtf(ss * (1.f / 1024.f) + 1e-6f);
            const u32x2* yr = (const u32x2*)((const bf16*)(p.ws + WS_YCAT) + row * 1024) + lane; f32x4* orow = (f32x4*)(p.out + row * 1024) + lane;
#pragma unroll
            for (int j = 0; j < 4; ++j) { const u32x2 yw = yr[64 * j]; const f32x4 y = {bflo(yw.x), bfhi(yw.x), bflo(yw.y), bfhi(yw.y)}; const f32x4 a1 = ((const f32x4*)A1)[64 * j + lane];
                orow[64 * j] = orow[64 * j] + a1 * y * r1; } }
    }
}

__device__ __forceinline__ float gelu_tanh(float x) { const float u = 0.7978845608f * (x + 0.044715f * x * x * x); const float e = __builtin_amdgcn_exp2f(2.885390082f * u); return 0.5f * x * (2.f - 2.f * __builtin_amdgcn_rcpf(1.f + e)); }
__device__ __forceinline__ void phase_cmp2_conv(const Params& p, unsigned char* lds, int gw, int NGW, int wave, int lane) {
    unsigned char* ws = p.ws;
    float* hs = (float*)(lds + wave * 1024);
    const bf16* HC = (const bf16*)(ws + WS_HC); const float* CBP = (const float*)(ws + WS_CBP);
    for (int it = gw; it < 16384; it += NGW) {
        const int kv = it >> 13, bg = (it >> 9) & 15, cc = it & 511; const size_t row = (size_t)it;
        float o = 0.f;
        if (cc < 511) {
            const float* w2 = kv ? p.w_cv2 : p.w_ck2;
#pragma unroll
            for (int hh = 0; hh < 2; ++hh) { const int n = lane + 64 * hh; float bsum = 0.f;
#pragma unroll
                for (int kc = 0; kc < 16; ++kc) bsum += CBP[(kv * 16 + kc) * 128 + n];
                const float pre = bflo((unsigned)HC[row * 256 + n]) + bflo((unsigned)HC[(row + 1) * 256 + 128 + n]) + bsum;
                hs[n] = gelu_tanh(pre); }
            LDS_WAIT();
#pragma unroll 8
            for (int n = 0; n < 128; ++n) o += hs[n] * w2[n * 64 + lane];
            LDS_WAIT();
        }
        const bf16 ob = (bf16)(cvtpk(o, 0.f) & 0xffffu);
        if (kv == 0) ((bf16*)(ws + WS_KCC))[((size_t)bg * 512 + cc) * 64 + lane] = ob;
        else ((bf16*)(ws + WS_VCT))[((size_t)bg * 64 + lane) * 512 + cc] = ob;
    }
    const bf16* U = (const bf16*)(ws + WS_U); bf16* YC = (bf16*)(ws + WS_YCAT);
    float cw[3][8], gco[8];
#pragma unroll
    for (int w = 0; w < 3; ++w)
#pragma unroll
        for (int e = 0; e < 8; ++e) cw[w][e] = p.conv_w[w * 512 + 8 * lane + e];
#pragma unroll
    for (int e = 0; e < 8; ++e) gco[e] = p.g_conv_out[8 * lane + e];
    for (int it = gw; it < MTOK / 32; it += NGW) {
        const int t0 = it * 32; float z1[8], z2[8];
#pragma unroll
        for (int e = 0; e < 8; ++e) { z1[e] = 0.f; z2[e] = 0.f; }
        if ((t0 & (SEQ - 1)) != 0) {
#pragma unroll
            for (int bk = 1; bk <= 2; ++bk) { const bf16* ur = U + (size_t)(t0 - bk) * 2048 + 8 * lane; const u32x4 cg_ = *(const u32x4*)(ur + 512), vv = *(const u32x4*)(ur + 1024);
                float* z = bk == 1 ? z1 : z2;
                z[0] = bflo(cg_.x) * bflo(vv.x); z[1] = bfhi(cg_.x) * bfhi(vv.x); z[2] = bflo(cg_.y) * bflo(vv.y); z[3] = bfhi(cg_.y) * bfhi(vv.y);
                z[4] = bflo(cg_.z) * bflo(vv.z); z[5] = bfhi(cg_.z) * bfhi(vv.z); z[6] = bflo(cg_.w) * bflo(vv.w); z[7] = bfhi(cg_.w) * bfhi(vv.w); }
        }
        for (int tt = 0; tt < 32; ++tt) { const bf16* ur = U + (size_t)(t0 + tt) * 2048 + 8 * lane;
            const u32x4 bg_ = *(const u32x4*)ur, cg_ = *(const u32x4*)(ur + 512), vv = *(const u32x4*)(ur + 1024); float z0[8], bgf[8], y[8];
            z0[0] = bflo(cg_.x) * bflo(vv.x); z0[1] = bfhi(cg_.x) * bfhi(vv.x); z0[2] = bflo(cg_.y) * bflo(vv.y); z0[3] = bfhi(cg_.y) * bfhi(vv.y);
            z0[4] = bflo(cg_.z) * bflo(vv.z); z0[5] = bfhi(cg_.z) * bfhi(vv.z); z0[6] = bflo(cg_.w) * bflo(vv.w); z0[7] = bfhi(cg_.w) * bfhi(vv.w);
            bgf[0] = bflo(bg_.x); bgf[1] = bfhi(bg_.x); bgf[2] = bflo(bg_.y); bgf[3] = bfhi(bg_.y); bgf[4] = bflo(bg_.z); bgf[5] = bfhi(bg_.z); bgf[6] = bflo(bg_.w); bgf[7] = bfhi(bg_.w);
            float s = 0.f;
#pragma unroll
            for (int e = 0; e < 8; ++e) { y[e] = bgf[e] * (cw[0][e] * z2[e] + cw[1][e] * z1[e] + cw[2][e] * z0[e]); s += y[e] * y[e]; z2[e] = z1[e]; z1[e] = z0[e]; }
            const float rs = rsqrtf(wave_sum(s) * (1.f / 512.f) + 1e-6f);
            u32x4 o; o.x = cvtpk(y[0] * rs * gco[0], y[1] * rs * gco[1]); o.y = cvtpk(y[2] * rs * gco[2], y[3] * rs * gco[3]); o.z = cvtpk(y[4] * rs * gco[4], y[5] * rs * gco[5]); o.w = cvtpk(y[6] * rs * gco[6], y[7] * rs * gco[7]);
            *(u32x4*)(YC + (size_t)(t0 + tt) * 1024 + 8 * lane) = o; }
    }
}

#define MFMA16(a, b, c) __builtin_amdgcn_mfma_f32_16x16x32_bf16((a), (b), (c), 0, 0, 0)
constexpr float CEXP = 0.18033688011f;
constexpr float NEGB = -1e30f;

template <int MODE>
__device__ __forceinline__ void attn_unit(const char* Kp  , unsigned voffK, const char* VTp  , unsigned vstep  , unsigned voffV,
                                          const float (&base)[2][4], const float (&sl8)[4],
                                          const bf16x8* QS, f32x4 (&O)[4][4], float (&m)[4], float (&l)[4], const float (&linv)[4], float (&psum)[2][4]) {
    bf16x8 kf[2][2], vf[4];
#pragma unroll
    for (int od = 0; od < 2; ++od)
#pragma unroll
        for (int ks = 0; ks < 2; ++ks) kf[od][ks] = *(const bf16x8*)(Kp + voffK + (od * 512 + ks * 64));
    if (MODE != 0) {
#pragma unroll
        for (int ds = 0; ds < 4; ++ds) vf[ds] = *(const bf16x8*)(VTp + (size_t)ds * vstep + voffV);
    }
    if (MODE == 1) {
#pragma unroll
        for (int od = 0; od < 2; ++od)
#pragma unroll
            for (int i = 0; i < 4; ++i) psum[od][i] = 0.f;
    }
#pragma unroll
    for (int h = 0; h < 4; ++h) {
        f32x4 a0, a1;
#pragma unroll
        for (int i = 0; i < 4; ++i) { a0[i] = base[0][i] * sl8[h]; a1[i] = base[1][i] * sl8[h]; }
#pragma unroll
        for (int ks = 0; ks < 2; ++ks) { const bf16x8 qv = QS[(h * 2 + ks) * 64]; a0 = MFMA16(kf[0][ks], qv, a0); a1 = MFMA16(kf[1][ks], qv, a1); }
        float p0[4], p1[4];
        if (MODE == 1) {
#pragma unroll
            for (int i = 0; i < 4; ++i) { p0[i] = __builtin_amdgcn_exp2f((a0[i] - m[h]) * CEXP) * linv[h]; p1[i] = __builtin_amdgcn_exp2f((a1[i] - m[h]) * CEXP) * linv[h]; psum[0][i] += p0[i]; psum[1][i] += p1[i]; }
        } else {
            float tm = fmaxf(fmaxf(fmaxf(a0[0], a0[1]), fmaxf(a0[2], a0[3])), fmaxf(fmaxf(a1[0], a1[1]), fmaxf(a1[2], a1[3])));
            tm = fmaxf(tm, __shfl_xor(tm, 16)); tm = fmaxf(tm, __shfl_xor(tm, 32));
            const float mn = fmaxf(m[h], tm), alpha = __builtin_amdgcn_exp2f((m[h] - mn) * CEXP); m[h] = mn;
            float ps = 0.f;
#pragma unroll
            for (int i = 0; i < 4; ++i) { p0[i] = __builtin_amdgcn_exp2f((a0[i] - mn) * CEXP); p1[i] = __builtin_amdgcn_exp2f((a1[i] - mn) * CEXP); ps += p0[i] + p1[i]; }
            l[h] = l[h] * alpha + ps;
            if (MODE == 2) {
#pragma unroll
                for (int ds = 0; ds < 4; ++ds) O[h][ds] = O[h][ds] * alpha;
            }
        }
        if (MODE != 0) {
            u32x4 pw; pw.x = cvtpk(p0[0], p0[1]); pw.y = cvtpk(p0[2], p0[3]); pw.z = cvtpk(p1[0], p1[1]); pw.w = cvtpk(p1[2], p1[3]);
            const bf16x8 pf = __builtin_bit_cast(bf16x8, pw);
#pragma unroll
            for (int ds = 0; ds < 4; ++ds) O[h][ds] = MFMA16(vf[ds], pf, O[h][ds]);
        }
    }
}

__device__ __forceinline__ void phase_attn(const Params& p, unsigned char* lds, int gw, int NGW, int wave, int lane) {
    unsigned char* ws = p.ws;
    const bf16* U = (const bf16*)(ws + WS_U); const float* GATES = (const float*)(ws + WS_GATES);
    const bf16* KCC = (const bf16*)(ws + WS_KCC); const bf16* VCT = (const bf16*)(ws + WS_VCT);
    const bf16* KS = (const bf16*)(ws + WS_KS); const bf16* KW = (const bf16*)(ws + WS_KW); const bf16* VST = (const bf16*)(ws + WS_VST); const bf16* VWT = (const bf16*)(ws + WS_VWT);
    bf16* YC = (bf16*)(ws + WS_YCAT);
    bf16x8* QSW = (bf16x8*)(lds + wave * 16640);
    const bf16x8* QS = QSW + lane;
    float* IMP = (float*)(lds + wave * 16640 + 8192);
    f32x4* FW = (f32x4*)(ws + WS_FSCR) + (size_t)gw * 1024 + lane * 16;
    const int qi = lane & 15, g4 = lane >> 4;
    const unsigned voffK = (unsigned)((8 * (qi >> 2) + (qi & 3)) * 128 + 16 * g4), voffV = (unsigned)(qi * SEQ * 2 + 16 * g4), voffVc = (unsigned)(qi * 512 * 2 + 16 * g4);
    for (int item = gw; item < 8192; item += NGW) {
        const int bi = item >> 3, bg = bi & 15, qt = (63 - (bi >> 4)) * 8 + (item & 7), g = bg & 1, b = bg >> 1;
        const int q0 = qt * 16, t = q0 + qi, cur = q0 >> 6;
        const size_t tokrow = (size_t)b * SEQ + t;
        float sl8[4];
#pragma unroll
        for (int h = 0; h < 4; ++h) { sl8[h] = 8.f * __builtin_amdgcn_exp2f(-(float)(g * 4 + h + 1));
#pragma unroll
            for (int ks = 0; ks < 2; ++ks) QSW[(h * 2 + ks) * 64 + lane] = *(const bf16x8*)(U + tokrow * 2048 + 1536 + (g * 4 + h) * 64 + 32 * ks + 8 * g4); }
        f32x4 O[4][4]; float m[4], l[4], linv[4], psum[2][4], base[2][4];
#pragma unroll
        for (int k = 0; k < 33; ++k) { const int idx = lane + 64 * k; if (idx < 16 * 129) IMP[idx] = 0.f; }
#pragma unroll
        for (int h = 0; h < 4; ++h) { m[h] = -1e20f; l[h] = 0.f; linv[h] = 0.f;
#pragma unroll
            for (int ds = 0; ds < 4; ++ds) O[h][ds] = (f32x4){0.f, 0.f, 0.f, 0.f}; }
        const int nun = (qt + 31) >> 5;
        const int cimax = (t - 31) >> 4;
        const char* Kc = (const char*)(KCC + (size_t)bg * 512 * 64); const char* Vc = (const char*)(VCT + (size_t)bg * 64 * 512);
#pragma unroll 1
        for (int u = 0; u < nun; ++u) { const int kb = 32 * u;
#pragma unroll
            for (int od = 0; od < 2; ++od)
#pragma unroll
                for (int i = 0; i < 4; ++i) { const int ci = kb + 8 * g4 + 4 * od + i; base[od][i] = ci <= cimax ? (float)(16 * ci - q0) : NEGB; }
            attn_unit<0>(Kc + (size_t)kb * 128, voffK, nullptr, 0u, 0u, base, sl8, QS, O, m, l, linv, psum); }
#pragma unroll
        for (int h = 0; h < 4; ++h) { float lt = l[h]; lt += __shfl_xor(lt, 16); lt += __shfl_xor(lt, 32); linv[h] = lt > 0.f ? 1.f / lt : 0.f; }
#pragma unroll 1
        for (int u = 0; u < nun; ++u) { const int kb = 32 * u;
#pragma unroll
            for (int od = 0; od < 2; ++od)
#pragma unroll
                for (int i = 0; i < 4; ++i) { const int ci = kb + 8 * g4 + 4 * od + i; base[od][i] = ci <= cimax ? (float)(16 * ci - q0) : NEGB; }
            attn_unit<1>(Kc + (size_t)kb * 128, voffK, Vc + (size_t)kb * 2, 16u * 512u * 2u, voffVc, base, sl8, QS, O, m, l, linv, psum);
#pragma unroll
            for (int od = 0; od < 2; ++od) { const int jb = (kb >> 2) + 2 * g4 + od;
                atomicAdd(&IMP[qi * 129 + jb], (psum[od][0] + psum[od][1]) + (psum[od][2] + psum[od][3]));
                atomicAdd(&IMP[qi * 129 + jb + 1], psum[od][3]); } }
#pragma unroll
        for (int h = 0; h < 4; ++h)
#pragma unroll
            for (int ds = 0; ds < 4; ++ds) FW[h * 4 + ds] = O[h][ds] * GATES[tokrow * 24 + (g * 4 + h) * 3 + 0];
        LDS_WAIT();
        unsigned sel[4];
        if (cur >= 16) {
            unsigned key[32];
#pragma unroll
            for (int e = 0; e < 32; ++e) { const int jb = 32 * g4 + e; const float v = IMP[qi * 129 + jb]; key[e] = (jb >= 1 && jb <= cur - 2) ? ((__float_as_uint(v) & 0xFFFFFF80u) | (unsigned)(127 - jb)) : 0u; }
            unsigned mymask = 0u;
#pragma unroll 1
            for (int r = 0; r < 13; ++r) {
                unsigned mk = 0u;
#pragma unroll
                for (int e = 0; e < 32; ++e) mk = key[e] > mk ? key[e] : mk;
                unsigned o1 = (unsigned)__shfl_xor((int)mk, 16); mk = o1 > mk ? o1 : mk; o1 = (unsigned)__shfl_xor((int)mk, 32); mk = o1 > mk ? o1 : mk;
                const int jw = 127 - (int)(mk & 127u);
                if ((jw >> 5) == g4) mymask |= 1u << (jw & 31);
#pragma unroll
                for (int e = 0; e < 32; ++e) key[e] = key[e] == mk ? 0u : key[e];
            }
#pragma unroll
            for (int gg = 0; gg < 4; ++gg) { unsigned s = (unsigned)__shfl((int)mymask, 16 * gg + qi);
                if (gg == 0) s |= 1u;
                if (((cur - 1) >> 5) == gg) s |= 1u << ((cur - 1) & 31);
                if ((cur >> 5) == gg) s |= 1u << (cur & 31);
                sel[gg] = s; }
        } else { sel[0] = (2u << cur) - 1u; sel[1] = 0u; sel[2] = 0u; sel[3] = 0u; }
        unsigned un[4];
#pragma unroll
        for (int gg = 0; gg < 4; ++gg) { unsigned v = sel[gg]; v |= (unsigned)__shfl_xor((int)v, 1); v |= (unsigned)__shfl_xor((int)v, 2); v |= (unsigned)__shfl_xor((int)v, 4); v |= (unsigned)__shfl_xor((int)v, 8);
            un[gg] = (unsigned)__builtin_amdgcn_readfirstlane((int)v); }
#pragma unroll
        for (int h = 0; h < 4; ++h) { m[h] = -1e20f; l[h] = 0.f;
#pragma unroll
            for (int ds = 0; ds < 4; ++ds) O[h][ds] = (f32x4){0.f, 0.f, 0.f, 0.f}; }
        {
            const char* Kb = (const char*)(KS + (size_t)bg * SEQ * 64); const char* Vb = (const char*)(VST + (size_t)bg * 64 * SEQ);
#pragma unroll
            for (int gg = 0; gg < 4; ++gg) { unsigned um = un[gg];
                while (um) { const int bit = __builtin_ctz(um); um &= um - 1u; const int jb = 32 * gg + bit; const bool selq = (sel[gg] >> bit) & 1u;
#pragma unroll 1
                    for (int hf = 0; hf < 2; ++hf) { const int kb = 64 * jb + 32 * hf;
#pragma unroll
                        for (int od = 0; od < 2; ++od)
#pragma unroll
                            for (int i = 0; i < 4; ++i) { const int kpos = kb + 8 * g4 + 4 * od + i; base[od][i] = (selq && kpos <= t) ? (float)(kpos - q0) : NEGB; }
                        attn_unit<2>(Kb + (size_t)kb * 128, voffK, Vb + (size_t)kb * 2, 16u * SEQ * 2u, voffV, base, sl8, QS, O, m, l, linv, psum); } } }
        }
#pragma unroll
        for (int h = 0; h < 4; ++h) { float lt = l[h]; lt += __shfl_xor(lt, 16); lt += __shfl_xor(lt, 32); const float f = lt > 0.f ? GATES[tokrow * 24 + (g * 4 + h) * 3 + 1] / lt : 0.f;
#pragma unroll
            for (int ds = 0; ds < 4; ++ds) FW[h * 4 + ds] = FW[h * 4 + ds] + O[h][ds] * f; }
#pragma unroll
        for (int h = 0; h < 4; ++h) { m[h] = -1e20f; l[h] = 0.f;
#pragma unroll
            for (int ds = 0; ds < 4; ++ds) O[h][ds] = (f32x4){0.f, 0.f, 0.f, 0.f}; }
        {
            const char* Kb = (const char*)(KW + (size_t)bg * SEQ * 64); const char* Vb = (const char*)(VWT + (size_t)bg * 64 * SEQ);
            const int kb0 = q0 >= 511 ? ((q0 - 511) & ~31) : 0;
#pragma unroll 1
            for (int kb = kb0; kb <= q0 + 15; kb += 32) {
#pragma unroll
                for (int od = 0; od < 2; ++od)
#pragma unroll
                    for (int i = 0; i < 4; ++i) { const int kpos = kb + 8 * g4 + 4 * od + i, dd = t - kpos; base[od][i] = (dd >= 0 && dd < 512) ? (float)(kpos - q0) : NEGB; }
                attn_unit<2>(Kb + (size_t)kb * 128, voffK, Vb + (size_t)kb * 2, 16u * SEQ * 2u, voffV, base, sl8, QS, O, m, l, linv, psum); }
        }
#pragma unroll
        for (int h = 0; h < 4; ++h) { float lt = l[h]; lt += __shfl_xor(lt, 16); lt += __shfl_xor(lt, 32); const float f = lt > 0.f ? GATES[tokrow * 24 + (g * 4 + h) * 3 + 2] / lt : 0.f; float ss = 0.f;
#pragma unroll
            for (int ds = 0; ds < 4; ++ds) { O[h][ds] = FW[h * 4 + ds] + O[h][ds] * f; ss += (O[h][ds][0] * O[h][ds][0] + O[h][ds][1] * O[h][ds][1]) + (O[h][ds][2] * O[h][ds][2] + O[h][ds][3] * O[h][ds][3]); }
            ss += __shfl_xor(ss, 16); ss += __shfl_xor(ss, 32);
            const float rs = rsqrtf(ss * (1.f / 64.f) + 1e-6f);
#pragma unroll
            for (int ds = 0; ds < 4; ++ds) { const int dcol = (g * 4 + h) * 64 + 16 * ds + 4 * g4; const f32x4 gg_ = *(const f32x4*)(p.g_attn_out + dcol); const f32x4 y = O[h][ds] * rs * gg_;
                u32x2 w; w.x = cvtpk(y[0], y[1]); w.y = cvtpk(y[2], y[3]); *(u32x2*)(YC + tokrow * 1024 + 512 + dcol) = w; } }
        LDS_WAIT();
    }
}

__global__ void __launch_bounds__(NTHREADS, 2) fwd_kernel(Params p) {
    extern __shared__ __attribute__((aligned(16))) unsigned char lds[];
    cg::grid_group grid = cg::this_grid();
    const int wave = __builtin_amdgcn_readfirstlane(threadIdx.x >> 6);
    const int G = gridDim.x, gw = blockIdx.x * NWAVES + wave, NGW = G * NWAVES;
    PG8_LAS unsigned char* ldsl = (PG8_LAS unsigned char*)lds;
    unsigned char* ws = p.ws;

    phase0(p, lds, gw, NGW, wave, pg8::fresh_lane());
    grid.sync();
    { const int ln = pg8::fresh_lane(); phase_norm1(p, lds, wave * 64 + ln, wave, ln); }
    grid.sync();
    {
        pg8::Gemm g{(const pg8::bf16_t*)(ws + WS_H), (const pg8::bf16_t*)(ws + WS_WIN), MTOK, NINP, 1024};
        pg8::StaticOrder S; S.init(MTOK, NINP, G, (int)blockIdx.x);
        pg8::EpiIn E{(pg8::bf16_t*)(ws + WS_U), (pg8::bf16_t*)(ws + WS_KC), (pg8::bf16_t*)(ws + WS_KS), (pg8::bf16_t*)(ws + WS_KW), (pg8::bf16_t*)(ws + WS_VST), (pg8::bf16_t*)(ws + WS_VWT), (float*)(ws + WS_GATES)};
        pg8::gemm_phase<pg8::EpiIn, pg8::StaticOrder, true, true>(ldsl, g, S, E);
    }
    grid.sync();
    {
        pg8::Gemm gk{(const pg8::bf16_t*)(ws + WS_KC), (const pg8::bf16_t*)(ws + WS_W1K), 8192, 256, 1024};
        pg8::StaticOrder S; S.init(8192, 256, G, (int)blockIdx.x);
        pg8::EpiPlain E{(pg8::bf16_t*)(ws + WS_HC), 256};
        pg8::gemm_phase<pg8::EpiPlain, pg8::StaticOrder, true, true>(ldsl, gk, S, E);
        pg8::Gemm gv{(const pg8::bf16_t*)(ws + WS_KC) + (size_t)8192 * 1024, (const pg8::bf16_t*)(ws + WS_W1V), 8192, 256, 1024};
        pg8::StaticOrder S2; S2.init(8192, 256, G, (int)((blockIdx.x + G - 32) % G));
        pg8::EpiPlain E2{(pg8::bf16_t*)(ws + WS_HC) + (size_t)8192 * 256, 256};
        pg8::gemm_phase<pg8::EpiPlain, pg8::StaticOrder, true, true>(ldsl, gv, S2, E2);
    }
    grid.sync();
    phase_cmp2_conv(p, lds, gw, NGW, wave, pg8::fresh_lane());
    grid.sync();
#ifndef NO_ATTN
    phase_attn(p, lds, gw, NGW, wave, pg8::fresh_lane());
#endif
    grid.sync();
    {
        pg8::Gemm g{(const pg8::bf16_t*)(ws + WS_YCAT), (const pg8::bf16_t*)(ws + WS_WOUT), MTOK, 1024, 1024};
        pg8::StaticOrder S; S.init(MTOK, 1024, G, (int)blockIdx.x);
        pg8::EpiRow E{(pg8::bf16_t*)(ws + WS_Y), (float*)(ws + WS_RSS1)};
        pg8::gemm_phase<pg8::EpiRow, pg8::StaticOrder, true, true>(ldsl, g, S, E);
    }
    grid.sync();
    { const int ln = pg8::fresh_lane(); phase_mid(p, lds, wave * 64 + ln, wave, ln); }
    grid.sync();
    {
        pg8::Gemm g{(const pg8::bf16_t*)(ws + WS_H), (const pg8::bf16_t*)(ws + WS_WGU), MTOK, 2 * DFF, 1024};
        pg8::StaticOrder S; S.init(MTOK, 2 * DFF, G, (int)blockIdx.x);
        pg8::EpiGU E{(pg8::bf16_t*)(ws + WS_ACT)};
        pg8::gemm_phase<pg8::EpiGU, pg8::StaticOrder, true, true>(ldsl, g, S, E);
    }
    grid.sync();
    {
        pg8::Gemm g{(const pg8::bf16_t*)(ws + WS_ACT), (const pg8::bf16_t*)(ws + WS_WDN), MTOK, 1024, DFF};
        pg8::StaticOrder S; S.init(MTOK, 1024, G, (int)blockIdx.x);
        pg8::EpiRow E{(pg8::bf16_t*)(ws + WS_YCAT), (float*)(ws + WS_RSS2)};
        pg8::gemm_phase<pg8::EpiRow, pg8::StaticOrder, true, true>(ldsl, g, S, E);
    }
    grid.sync();
    { const int ln = pg8::fresh_lane(); phase_final(p, lds, wave * 64 + ln, wave, ln); }
}

extern "C" void kernel_launch(void* const* d_in, const int* in_sizes, int n_in, void* d_out, int out_size, void* d_ws, size_t ws_size, hipStream_t stream) {
    static int grid = 0;
    if (grid == 0) {
        if (n_in != 21 || ws_size < WS_END) { fprintf(stderr, "kernel_launch: unexpected n_in %d / ws %zu\n", n_in, ws_size); grid = -1; return; }
        int dev = 0, cus = 0, per_cu = 0;
        hipGetDevice(&dev); hipDeviceGetAttribute(&cus, hipDeviceAttributeMultiprocessorCount, dev);
        if (hipFuncSetAttribute((const void*)fwd_kernel, hipFuncAttributeMaxDynamicSharedMemorySize, LDS_BYTES) != hipSuccess) { fprintf(stderr, "kernel_launch: hipFuncSetAttribute failed\n"); grid = -1; return; }
        if (hipOccupancyMaxActiveBlocksPerMultiprocessor(&per_cu, (const void*)fwd_kernel, NTHREADS, LDS_BYTES) != hipSuccess || per_cu < 1) { fprintf(stderr, "kernel_launch: occupancy query says %d\n", per_cu); per_cu = 1; }
        (void)hipGetLastError();
        grid = cus * 1;
    }
    if (grid < 0) return;
    Params p{};
    const float** pp = (const float**)&p;
    for (int i = 0; i < 21; ++i) pp[i] = (const float*)d_in[i];
    p.out = (float*)d_out; p.ws = (unsigned char*)d_ws;
    void* args[] = {&p};
    hipError_t e = hipLaunchCooperativeKernel((const void*)fwd_kernel, dim3(grid), dim3(NTHREADS), args, LDS_BYTES, stream);
    if (e != hipSuccess) fprintf(stderr, "cooperative launch failed: %s (grid %d)\n", hipGetErrorString(e), grid);
}
```

```cpp
#include <hip/hip_runtime.h>
#include <hip/hip_cooperative_groups.h>
#include <cstdio>
#include <cstdint>
namespace cg = cooperative_groups;
namespace pg8 {
#define PG8_LAS __attribute__((address_space(3)))
typedef unsigned short bf16_t;
typedef short bf16x8 __attribute__((ext_vector_type(8)));
typedef float f32x4 __attribute__((ext_vector_type(4)));
typedef unsigned u32x4 __attribute__((ext_vector_type(4)));
constexpr int BM = 256, BK = 64, HALF = 128, HTB = HALF * BK * 2  , STAGE_BYTES = 8 * HTB, NXCD = 8, WGM = 8;

__host__ __device__ __forceinline__ int lds_byte(int r, int c) { const int st = (r >> 4) * 2 + (c >> 5), rr = r & 15, cc = c & 31, ob = rr * 64 + cc * 2; return st * 1024 + (ob ^ (((ob >> 9) & 1) << 5)); }
__host__ __device__ __forceinline__ void stage_rc(int b, int& R, int& C) { const int st = b / 1024, sb = b % 1024, swz = sb ^ (((sb >> 9) & 1) << 5); R = (st >> 1) * 16 + swz / 64; C = (st & 1) * 32 + (swz % 64) / 2; }
__host__ __device__ __forceinline__ int perm32(int rho) { const int n = rho >> 4, i = rho & 15; return 8 * (i >> 2) + 4 * n + (i & 3); }

struct Unit { int pm, pn; };
struct Gemm { const bf16_t* A; const bf16_t* Bt; int M, N, K; };

struct StaticOrder {
    int nM, nN, nwg, G, c;
    __host__ __device__ void init(int M, int N, int G_, int c_) { nM = M / BM; nN = N / BM; nwg = nM * nN; G = G_; c = c_; }
    __host__ __device__ bool next(int i, Unit& u) const {
        const long L = (long)i * G + c; if (L >= nwg) return false;
        int wgid = (int)L; { const int q = nwg / NXCD, r = nwg % NXCD, xcd = wgid % NXCD, off = wgid / NXCD; wgid = (xcd < r ? xcd * (q + 1) : r * (q + 1) + (xcd - r) * q) + off; }
        const int nig = WGM * nN, gid = wgid / nig, fm = gid * WGM, gsz = (nM - fm) < WGM ? (nM - fm) : WGM;
        u.pm = fm + ((wgid % nig) % gsz); u.pn = (wgid % nig) / gsz; return true;
    }
    __device__ __forceinline__ void a_ready(const Unit&) const {}
    __device__ __forceinline__ void done(const Unit&) const {}
};

__device__ __forceinline__ unsigned cvt_pk_bf16(float lo, float hi) { unsigned r; asm volatile("v_cvt_pk_bf16_f32 %0, %1, %2" : "=v"(r) : "v"(lo), "v"(hi)); return r; }
typedef float f32x2 __attribute__((ext_vector_type(2)));
__device__ __forceinline__ int fresh_lane() { int l; asm volatile("v_mbcnt_lo_u32_b32 %0, -1, 0\n\tv_mbcnt_hi_u32_b32 %0, -1, %0" : "=v"(l)); return l; }
typedef unsigned u32x2 __attribute__((ext_vector_type(2)));
__device__ __forceinline__ u32x4 pack8(const f32x4& v0, const f32x4& v1) { u32x4 w; w.x = cvt_pk_bf16(v0[0], v0[1]); w.y = cvt_pk_bf16(v0[2], v0[3]); w.z = cvt_pk_bf16(v1[0], v1[1]); w.w = cvt_pk_bf16(v1[2], v1[3]); return w; }
struct EpiPlain {
    static constexpr bool PERM = true, AFTER_DRAIN = false;
    bf16_t* O; int ldc;
    __device__ __forceinline__ void operator()(const f32x4 (&acc)[2][2][4][2], const Unit& u, int wr, int wc, int fr, int fq) const {
        const int row0 = u.pm * BM + wr * 64 + fr, col0 = u.pn * BM + wc * 32 + 8 * fq;
#pragma unroll
        for (int ai = 0; ai < 2; ++ai)
#pragma unroll
            for (int m = 0; m < 4; ++m) { bf16_t* rowp = O + (size_t)(row0 + ai * HALF + m * 16) * ldc + col0;
#pragma unroll
                for (int bj = 0; bj < 2; ++bj) *(u32x4*)(rowp + bj * HALF) = pack8(acc[ai][bj][m][0], acc[ai][bj][m][1]); }
    }
};
struct EpiRow {
    static constexpr bool PERM = true, AFTER_DRAIN = false;
    bf16_t* O; float* RSS;
    __device__ __forceinline__ void operator()(const f32x4 (&acc)[2][2][4][2], const Unit& u, int wr, int wc, int fr, int fq) const {
        const int row0 = u.pm * BM + wr * 64 + fr, col0 = u.pn * BM + wc * 32 + 8 * fq;
#pragma unroll
        for (int ai = 0; ai < 2; ++ai)
#pragma unroll
            for (int m = 0; m < 4; ++m) { const int row = row0 + ai * HALF + m * 16; bf16_t* rowp = O + (size_t)row * 1024 + col0; float s = 0.f;
#pragma unroll
                for (int bj = 0; bj < 2; ++bj) { const f32x4 v0 = acc[ai][bj][m][0], v1 = acc[ai][bj][m][1];
                    s += (v0[0] * v0[0] + v0[1] * v0[1]) + (v0[2] * v0[2] + v0[3] * v0[3]) + (v1[0] * v1[0] + v1[1] * v1[1]) + (v1[2] * v1[2] + v1[3] * v1[3]);
                    *(u32x4*)(rowp + bj * HALF) = pack8(v0, v1); }
                s += __shfl_xor(s, 16); s += __shfl_xor(s, 32);
                if (fq == 0) RSS[(size_t)row * 16 + u.pn * 4 + wc] = s; }
    }
};
struct EpiGU {
    static constexpr bool PERM = true, AFTER_DRAIN = false;
    bf16_t* O;
    __device__ __forceinline__ void operator()(const f32x4 (&acc)[2][2][4][2], const Unit& u, int wr, int wc, int fr, int fq) const {
        const int row0 = u.pm * BM + wr * 64 + fr, col0 = (u.pn * BM + wc * 32 + 8 * fq) >> 1;
#pragma unroll
        for (int ai = 0; ai < 2; ++ai)
#pragma unroll
            for (int m = 0; m < 4; ++m) { bf16_t* rowp = O + (size_t)(row0 + ai * HALF + m * 16) * 2816 + col0;
#pragma unroll
                for (int bj = 0; bj < 2; ++bj) { const f32x4 g = acc[ai][bj][m][0], up = acc[ai][bj][m][1]; float a[4];
#pragma unroll
                    for (int i = 0; i < 4; ++i) a[i] = g[i] * __builtin_amdgcn_rcpf(1.f + __builtin_amdgcn_exp2f(-1.44269504f * g[i])) * up[i];
                    u32x2 w; w.x = cvt_pk_bf16(a[0], a[1]); w.y = cvt_pk_bf16(a[2], a[3]); *(u32x2*)(rowp + bj * (HALF / 2)) = w; } }
    }
};
struct EpiIn {
    static constexpr bool PERM = true, AFTER_DRAIN = false;
    bf16_t *U, *KC, *KS, *KW, *VST, *VWT; float* GATES;
    __device__ __forceinline__ void operator()(const f32x4 (&acc)[2][2][4][2], const Unit& u, int wr, int wc, int fr, int fq) const {
        const int row0 = u.pm * BM + wr * 64 + fr, pn = u.pn, c128 = wc * 32 + 8 * fq, g = c128 >> 6, d = c128 & 63;
#pragma unroll
        for (int ai = 0; ai < 2; ++ai)
#pragma unroll
            for (int m = 0; m < 4; ++m) { const int row = row0 + ai * HALF + m * 16, b = row >> 13, s = row & 8191;
#pragma unroll
                for (int bj = 0; bj < 2; ++bj) { const f32x4 v0 = acc[ai][bj][m][0], v1 = acc[ai][bj][m][1];
                    if (pn < 8) { *(u32x4*)(U + (size_t)row * 2048 + pn * BM + bj * HALF + c128) = pack8(v0, v1); }
                    else if (pn == 8) { *(u32x4*)(KC + ((size_t)((bj * 8 + b) * 2 + g) * 8192 + s) * 64 + d) = pack8(v0, v1); }
                    else if (pn <= 10) {
                        if (bj == 0) { bf16_t* K = (pn == 9) ? KS : KW; *(u32x4*)(K + ((size_t)(b * 2 + g) * 8192 + s) * 64 + d) = pack8(v0, v1); }
                        else { bf16_t* V = ((pn == 9) ? VST : VWT) + ((size_t)(b * 2 + g) * 64 + d) * 8192 + s; const u32x4 w = pack8(v0, v1);
                            V[0 * 8192] = (bf16_t)(w.x & 0xffffu); V[1 * 8192] = (bf16_t)(w.x >> 16); V[2 * 8192] = (bf16_t)(w.y & 0xffffu); V[3 * 8192] = (bf16_t)(w.y >> 16);
                            V[4 * 8192] = (bf16_t)(w.z & 0xffffu); V[5 * 8192] = (bf16_t)(w.z >> 16); V[6 * 8192] = (bf16_t)(w.w & 0xffffu); V[7 * 8192] = (bf16_t)(w.w >> 16); }
                    } else if (bj == 0 && c128 < 24) { f32x4 s0, s1;
#pragma unroll
                        for (int i = 0; i < 4; ++i) { s0[i] = __builtin_amdgcn_rcpf(1.f + __builtin_amdgcn_exp2f(-1.44269504f * v0[i])); s1[i] = __builtin_amdgcn_rcpf(1.f + __builtin_amdgcn_exp2f(-1.44269504f * v1[i])); }
                        *(f32x4*)(GATES + (size_t)row * 24 + c128) = s0; *(f32x4*)(GATES + (size_t)row * 24 + c128 + 4) = s1; }
                } }
    }
};
template <class Epi, class Sched, bool ALIGN_EPI = false, bool SP2 = false>
__device__ __forceinline__ void gemm_phase(PG8_LAS unsigned char* lds, const Gemm g, const Sched& S, const Epi& E, const int wid) {
    const int lane = fresh_lane(), tid = wid * 64 + lane, wr = wid >> 2, wc = wid & 3, fr = lane & 15, fq = lane >> 4;
    const int K = g.K, nt = K / BK;
    unsigned voffA[2], voffB[2];
#pragma unroll
    for (int i = 0; i < 2; ++i) { int R, C; stage_rc(tid * 16 + i * 8192, R, C); const int Rb = Epi::PERM ? ((R & ~31) + perm32(R & 31)) : R;
        voffA[i] = (unsigned)(R * K + C) * 2u; voffB[i] = (unsigned)(Rb * K + C) * 2u; }
    const size_t kstep = (size_t)(BK * 2);
    const size_t hstep = (size_t)HALF * K * 2;
    const size_t tstep = 2 * hstep;
    const unsigned ldsw = (unsigned)wid * 1024u;
    const int aoff = lds_byte(wr * 64 + fr, fq * 8), boff = lds_byte(wc * 32 + fr, fq * 8);
#define PG8_SA(b, h) (((b) * 2 + (h)) * HTB)
#define PG8_SB(b, h) ((4 + (b) * 2 + (h)) * HTB)
#define PG8_STAGE(bufoff, gbase, voff) do { _Pragma("unroll") for (int _i = 0; _i < 2; ++_i) \
        __builtin_amdgcn_global_load_lds((const unsigned*)((const char*)(gbase) + (voff)[_i]), (PG8_LAS unsigned*)(lds + (bufoff) + ldsw + _i * 8192), 16, 0, 0); } while (0)
#define PG8_LDA(dst, b, h) do { _Pragma("unroll") for (int m = 0; m < 4; ++m) _Pragma("unroll") for (int k = 0; k < 2; ++k) dst[m][k] = *(const PG8_LAS bf16x8*)(lds + PG8_SA(b, h) + aoff + m * 2048 + k * 1024); } while (0)
#define PG8_LDB(dst, b, h) do { _Pragma("unroll") for (int n = 0; n < 2; ++n) _Pragma("unroll") for (int k = 0; k < 2; ++k) dst[n][k] = *(const PG8_LAS bf16x8*)(lds + PG8_SB(b, h) + boff + n * 2048 + k * 1024); } while (0)
#define PG8_MMA(ai, bj, At, Bt) do { __builtin_amdgcn_s_setprio(1); _Pragma("unroll") for (int m = 0; m < 4; ++m) _Pragma("unroll") for (int n = 0; n < 2; ++n) _Pragma("unroll") for (int k = 0; k < 2; ++k) \
        acc[ai][bj][m][n] = __builtin_amdgcn_mfma_f32_16x16x32_bf16(Bt[n][k], At[m][k], acc[ai][bj][m][n], 0, 0, 0); __builtin_amdgcn_s_setprio(0); } while (0)
#define PG8_WAIT_V(n) asm volatile("s_waitcnt vmcnt(" #n ")" ::: "memory")
#define PG8_WAIT_L(n) asm volatile("s_waitcnt lgkmcnt(" #n ")" ::: "memory")
#define PG8_BAR __builtin_amdgcn_s_barrier()
#define PG8_SCHED __builtin_amdgcn_sched_barrier(0)
    Unit cur, nxt; int ui = 0;
    if (!S.next(0, cur)) return;
    f32x4 acc[2][2][4][2];
#pragma unroll
    for (int a = 0; a < 2; ++a)
#pragma unroll
        for (int b = 0; b < 2; ++b)
#pragma unroll
            for (int m = 0; m < 4; ++m)
#pragma unroll
                for (int n = 0; n < 2; ++n) acc[a][b][m][n] = (f32x4){0.f, 0.f, 0.f, 0.f};
    bf16x8 At[4][2], B0[2][2], B1[2][2];
    const char* cA = (const char*)g.A + (size_t)cur.pm * tstep; const char* cB = (const char*)g.Bt + (size_t)cur.pn * tstep;
    S.a_ready(cur);
    if constexpr (SP2) {
        PG8_STAGE(PG8_SB(0, 0), cB, voffB); PG8_STAGE(PG8_SB(0, 1), cB + hstep, voffB); PG8_STAGE(PG8_SA(0, 0), cA, voffA); PG8_STAGE(PG8_SA(0, 1), cA + hstep, voffA);
        if (wr == 1) PG8_BAR;
        PG8_WAIT_V(2); PG8_BAR;
        PG8_STAGE(PG8_SB(1, 0), cB + kstep, voffB); PG8_STAGE(PG8_SA(1, 0), cA + kstep, voffA); PG8_STAGE(PG8_SB(1, 1), cB + hstep + kstep, voffB);
        PG8_WAIT_V(6); PG8_BAR;
    } else {
        PG8_STAGE(PG8_SB(0, 0), cB, voffB); PG8_STAGE(PG8_SA(0, 0), cA, voffA); PG8_STAGE(PG8_SB(0, 1), cB + hstep, voffB); PG8_STAGE(PG8_SA(0, 1), cA + hstep, voffA);
        if (wr == 1) PG8_BAR;
        PG8_WAIT_V(4); PG8_BAR;
        PG8_STAGE(PG8_SB(1, 0), cB + kstep, voffB); PG8_STAGE(PG8_SA(1, 0), cA + kstep, voffA); PG8_STAGE(PG8_SB(1, 1), cB + hstep + kstep, voffB);
        PG8_WAIT_V(6); PG8_BAR;
    }
    for (;;) {
        const bool has_next = S.next(ui + 1, nxt);
        const char* nA = has_next ? (const char*)g.A + (size_t)nxt.pm * tstep : cA; const char* nB = has_next ? (const char*)g.Bt + (size_t)nxt.pn * tstep : cB;
        for (int t = 0; t < nt; t += 2) {
            const bool last = (t == nt - 2);
            const char* a1 = cA + (size_t)(t + 1) * kstep;
            const char* a2 = last ? nA : cA + (size_t)(t + 2) * kstep; const char* b2 = last ? nB : cB + (size_t)(t + 2) * kstep;
            const char* a3 = a2 + kstep; const char* b3 = b2 + kstep;
            if (last && has_next) S.a_ready(nxt);
            if constexpr (SP2) {
            PG8_LDB(B0, 0, 0); PG8_LDB(B1, 0, 1); PG8_SCHED; PG8_LDA(At, 0, 0); PG8_STAGE(PG8_SA(1, 1), a1 + hstep, voffA);
            PG8_WAIT_V(8); PG8_WAIT_L(0); PG8_BAR; PG8_MMA(0, 0, At, B0); PG8_MMA(0, 1, At, B1); PG8_BAR; PG8_SCHED;
            PG8_LDA(At, 0, 1); PG8_STAGE(PG8_SB(0, 0), b2, voffB); PG8_STAGE(PG8_SB(0, 1), b2 + hstep, voffB); PG8_STAGE(PG8_SA(0, 0), a2, voffA);
            PG8_WAIT_V(8); PG8_WAIT_L(0); PG8_BAR; PG8_MMA(1, 0, At, B0); PG8_MMA(1, 1, At, B1); PG8_BAR; PG8_SCHED;
            PG8_LDB(B0, 1, 0); PG8_LDB(B1, 1, 1); PG8_SCHED; PG8_LDA(At, 1, 0); PG8_STAGE(PG8_SA(0, 1), a2 + hstep, voffA);
            PG8_WAIT_V(8); PG8_WAIT_L(0); PG8_BAR; PG8_MMA(0, 0, At, B0); PG8_MMA(0, 1, At, B1); PG8_BAR; PG8_SCHED;
            PG8_LDA(At, 1, 1); PG8_STAGE(PG8_SB(1, 0), b3, voffB); PG8_STAGE(PG8_SB(1, 1), b3 + hstep, voffB); PG8_STAGE(PG8_SA(1, 0), a3, voffA);
            PG8_WAIT_V(8); PG8_WAIT_L(0); PG8_BAR; PG8_MMA(1, 0, At, B0); PG8_MMA(1, 1, At, B1); PG8_BAR; PG8_SCHED;
            } else {
            PG8_LDB(B0, 0, 0); PG8_SCHED; PG8_LDA(At, 0, 0); PG8_STAGE(PG8_SA(1, 1), a1 + hstep, voffA);
            PG8_WAIT_L(8); PG8_BAR; PG8_WAIT_L(0); PG8_MMA(0, 0, At, B0); PG8_BAR; PG8_SCHED;
            PG8_LDB(B1, 0, 1); PG8_STAGE(PG8_SB(0, 0), b2, voffB);
            PG8_BAR; PG8_WAIT_L(0); PG8_MMA(0, 1, At, B1); PG8_BAR;
            PG8_LDA(At, 0, 1); PG8_STAGE(PG8_SA(0, 0), a2, voffA);
            PG8_BAR; PG8_WAIT_L(0); PG8_MMA(1, 0, At, B0); PG8_BAR; PG8_SCHED;
            PG8_STAGE(PG8_SB(0, 1), b2 + hstep, voffB);
            PG8_WAIT_V(6); PG8_BAR; PG8_MMA(1, 1, At, B1); PG8_BAR;
            PG8_LDB(B0, 1, 0); PG8_SCHED; PG8_LDA(At, 1, 0); PG8_STAGE(PG8_SA(0, 1), a2 + hstep, voffA);
            PG8_WAIT_L(8); PG8_BAR; PG8_WAIT_L(0); PG8_MMA(0, 0, At, B0); PG8_BAR; PG8_SCHED;
            PG8_LDB(B1, 1, 1); PG8_STAGE(PG8_SB(1, 0), b3, voffB);
            PG8_BAR; PG8_WAIT_L(0); PG8_MMA(0, 1, At, B1); PG8_BAR;
            PG8_LDA(At, 1, 1); PG8_STAGE(PG8_SA(1, 0), a3, voffA);
            PG8_BAR; PG8_WAIT_L(0); PG8_MMA(1, 0, At, B0); PG8_BAR; PG8_SCHED;
            PG8_STAGE(PG8_SB(1, 1), b3 + hstep, voffB);
            PG8_WAIT_V(6); PG8_BAR; PG8_MMA(1, 1, At, B1); PG8_BAR;
            }
        }
        if constexpr (ALIGN_EPI) { if (wr == 0) PG8_BAR; }
        if constexpr (!Epi::AFTER_DRAIN) { E(acc, cur, wr, wc, fr, fq); S.done(cur); }
        if (!has_next) break;
#pragma unroll
        for (int a = 0; a < 2; ++a)
#pragma unroll
            for (int b = 0; b < 2; ++b)
#pragma unroll
                for (int m = 0; m < 4; ++m)
#pragma unroll
                    for (int n = 0; n < 2; ++n) acc[a][b][m][n] = (f32x4){0.f, 0.f, 0.f, 0.f};
        cur = nxt; cA = nA; cB = nB; ++ui;
        if constexpr (ALIGN_EPI) { if (wr == 1) PG8_BAR; }
    }
    PG8_WAIT_V(0);
    if constexpr (!ALIGN_EPI) { if (wr == 0) PG8_BAR; }
    PG8_BAR;
    if constexpr (Epi::AFTER_DRAIN) { E.fused(acc, cur, wr, wc, fr, fq, lds, wid, lane); S.done(cur); }
#undef PG8_SA
#undef PG8_SB
#undef PG8_STAGE
#undef PG8_LDA
#undef PG8_LDB
#undef PG8_MMA
#undef PG8_WAIT_V
#undef PG8_WAIT_L
#undef PG8_BAR
#undef PG8_SCHED
}
}

typedef unsigned short bf16;
typedef float f32x4 __attribute__((ext_vector_type(4)));
typedef short bf16x8 __attribute__((ext_vector_type(8)));
typedef unsigned u32x4 __attribute__((ext_vector_type(4)));
typedef unsigned u32x2 __attribute__((ext_vector_type(2)));
constexpr int NB = 8, SEQ = 8192, DM = 1024, MTOK = NB * SEQ, DIN = 2840, NINP = 3072, DFF = 2816;
constexpr int NWAVES = 8, NTHREADS = 512;
constexpr int LDS_BYTES = 147456;
constexpr size_t MiB = 1u << 20;
constexpr size_t WS_WIN = 0, WS_WOUT = 6 * MiB, WS_WGU = 8 * MiB, WS_WDN = 19 * MiB, WS_W1K = 25 * MiB, WS_W1V = WS_W1K + MiB / 2;
constexpr size_t WS_MODP = 26 * MiB;
constexpr size_t WS_CBP = 28 * MiB;
constexpr size_t WS_KCC = 29 * MiB, WS_VCT = 30 * MiB;
constexpr size_t WS_RSS1 = 32 * MiB, WS_RSS2 = 36 * MiB;
constexpr size_t WS_HC = 40 * MiB;
constexpr size_t WS_GATES = 48 * MiB;
constexpr size_t WS_H = 64 * MiB;
constexpr size_t WS_U = 192 * MiB;
constexpr size_t WS_KC = WS_U + 256 * MiB;
constexpr size_t WS_KS = WS_KC + 32 * MiB, WS_KW = WS_KS + 16 * MiB, WS_VST = WS_KW + 16 * MiB, WS_VWT = WS_VST + 16 * MiB;
constexpr size_t WS_ACT = WS_U;
constexpr size_t WS_YCAT = WS_U + 352 * MiB;
constexpr size_t WS_Y = WS_YCAT + 128 * MiB;
constexpr size_t WS_FSCR = WS_Y + 128 * MiB;
constexpr size_t WS_CTL = WS_FSCR + 32 * MiB;
constexpr size_t WS_END = WS_CTL + 1 * MiB;

struct Params {
    const float *x, *c, *w_mod, *b_mod, *g_pre_mix, *w_in, *conv_w, *pos_cmp, *w_ck1, *w_ck2, *w_cv1, *w_cv2, *g_conv_out, *g_attn_out, *w_out, *g_post_mix, *g_pre_ffn, *w_gate, *w_up, *w_down, *g_post_ffn;
    float* out; unsigned char* ws;
};

__device__ __forceinline__ unsigned cvtpk(float lo, float hi) { unsigned r; asm volatile("v_cvt_pk_bf16_f32 %0, %1, %2" : "=v"(r) : "v"(lo), "v"(hi)); return r; }
__device__ __forceinline__ float bflo(unsigned w) { return __uint_as_float(w << 16); }
__device__ __forceinline__ float bfhi(unsigned w) { return __uint_as_float(w & 0xffff0000u); }
__device__ __forceinline__ float wave_sum(float v) {
#pragma unroll
    for (int o = 1; o < 64; o <<= 1) v += __shfl_xor(v, o);
    return v;
}
#define LDS_WAIT() asm volatile("s_waitcnt lgkmcnt(0)" ::: "memory")

template <int MAP> __device__ __forceinline__ int rowmap(int n) { return MAP == 0 ? n : (MAP == 1 ? 8 * (n >> 2) + (n & 3) : 8 * (n >> 2) + 4 + (n & 3)); }
template <int MAP> __device__ __forceinline__ void p0_transpose_item(const float* W, int K, int N, bf16* WT, int row_off, float* scr, int item, int lane) {
    const int nblk = (N + 31) / 32, kb = item / nblk, nb = item % nblk, k0 = 64 * kb, n0 = 32 * nb;
    const int nn = n0 + (lane & 31);
#pragma unroll 8
    for (int i = 0; i < 32; ++i) { const int kk = 2 * i + (lane >> 5); scr[kk * 33 + (lane & 31)] = nn < N ? W[(size_t)(k0 + kk) * N + nn] : 0.f; }
    LDS_WAIT();
    const int c = lane & 7;
#pragma unroll
    for (int j = 0; j < 4; ++j) { const int n = (lane >> 3) + 8 * j; const float* s = scr + (8 * c) * 33 + n;
        u32x4 o; o.x = cvtpk(s[0 * 33], s[1 * 33]); o.y = cvtpk(s[2 * 33], s[3 * 33]); o.z = cvtpk(s[4 * 33], s[5 * 33]); o.w = cvtpk(s[6 * 33], s[7 * 33]);
        if (n0 + n < N) *(u32x4*)(WT + (size_t)(row_off + rowmap<MAP>(n0 + n)) * K + k0 + 8 * c) = o; }
    LDS_WAIT();
}

__device__ __forceinline__ void phase0(const Params& p, unsigned char* lds, int gw, int NGW, int wave, int lane) {
    unsigned char* ws = p.ws;
    float* scr = (float*)(lds + wave * 16384);
    constexpr int I_IN = 16 * 89, I_OUT = 16 * 32, I_G = 16 * 88, I_DN = 44 * 32, I_C1 = 16 * 4;
    constexpr int NT = I_IN + I_OUT + 2 * I_G + I_DN + 4 * I_C1;
    constexpr int I_MOD = 96 * 8, I_CB = 2 * 16;
    for (int it = gw; it < NT + I_MOD + I_CB; it += NGW) {
        int r = it;
        if (r < I_IN) { p0_transpose_item<0>(p.w_in, 1024, DIN, (bf16*)(ws + WS_WIN), 0, scr, r, lane); continue; } r -= I_IN;
        if (r < I_OUT) { p0_transpose_item<0>(p.w_out, 1024, 1024, (bf16*)(ws + WS_WOUT), 0, scr, r, lane); continue; } r -= I_OUT;
        if (r < I_G) { p0_transpose_item<1>(p.w_gate, 1024, DFF, (bf16*)(ws + WS_WGU), 0, scr, r, lane); continue; } r -= I_G;
        if (r < I_G) { p0_transpose_item<2>(p.w_up, 1024, DFF, (bf16*)(ws + WS_WGU), 0, scr, r, lane); continue; } r -= I_G;
        if (r < I_DN) { p0_transpose_item<0>(p.w_down, DFF, 1024, (bf16*)(ws + WS_WDN), 0, scr, r, lane); continue; } r -= I_DN;
        if (r < I_C1) { p0_transpose_item<0>(p.w_ck1, 1024, 128, (bf16*)(ws + WS_W1K), 0, scr, r, lane); continue; } r -= I_C1;
        if (r < I_C1) { p0_transpose_item<0>(p.w_ck1 + 1024 * 128, 1024, 128, (bf16*)(ws + WS_W1K), 128, scr, r, lane); continue; } r -= I_C1;
        if (r < I_C1) { p0_transpose_item<0>(p.w_cv1, 1024, 128, (bf16*)(ws + WS_W1V), 0, scr, r, lane); continue; } r -= I_C1;
        if (r < I_C1) { p0_transpose_item<0>(p.w_cv1 + 1024 * 128, 1024, 128, (bf16*)(ws + WS_W1V), 128, scr, r, lane); continue; } r -= I_C1;
        if (r < I_MOD) {
            const int cb = r >> 3, kc = r & 7, n = cb * 64 + lane; float a[8];
#pragma unroll
            for (int b = 0; b < 8; ++b) a[b] = 0.f;
            for (int k = kc * 128; k < kc * 128 + 128; ++k) { const float w = p.w_mod[(size_t)k * 6144 + n];
#pragma unroll
                for (int b = 0; b < 8; ++b) { const float cv = p.c[b * 1024 + k]; a[b] += cv * __builtin_amdgcn_rcpf(1.f + __builtin_amdgcn_exp2f(-1.44269504f * cv)) * w; } }
            float* MODP = (float*)(ws + WS_MODP);
#pragma unroll
            for (int b = 0; b < 8; ++b) MODP[(size_t)(kc * 8 + b) * 6144 + n] = a[b];
            continue; }
        r -= I_MOD;
        {
            const int kv = r >> 4, kc = r & 15; const float* w1 = kv ? p.w_cv1 : p.w_ck1; float a0 = 0.f, a1 = 0.f;
            for (int k = kc * 128; k < kc * 128 + 128; ++k) { const float pv = p.pos_cmp[k]; a0 += pv * w1[(size_t)k * 128 + lane]; a1 += pv * w1[(size_t)k * 128 + 64 + lane]; }
            float* CBP = (float*)(ws + WS_CBP);
            CBP[(kv * 16 + kc) * 128 + lane] = a0; CBP[(kv * 16 + kc) * 128 + 64 + lane] = a1; }
    }
}

__device__ __forceinline__ float mod_val(const Params& p, int b, int col) {
    const float* MODP = (const float*)(p.ws + WS_MODP); float s = p.b_mod[col];
#pragma unroll
    for (int kc = 0; kc < 8; ++kc) s += MODP[(size_t)(kc * 8 + b) * 6144 + col];
    return s;
}
__device__ __forceinline__ void phase_norm1(const Params& p, unsigned char* lds, int tid, int wave, int lane) {
    float* A = (float*)lds; float* Bv = A + 1024;
    for (int chunk = blockIdx.x; chunk < 256; chunk += gridDim.x) {
        const int b = chunk >> 5;
        __syncthreads();
        for (int col = tid; col < 1024; col += NTHREADS) { A[col] = p.g_pre_mix[col] * (1.f + mod_val(p, b, 1024 + col)); Bv[col] = mod_val(p, b, col); }
        __syncthreads();
        for (int r = wave; r < 128; r += NWAVES) { const size_t row = (size_t)chunk * 256 + r;
            const f32x4* xr = (const f32x4*)(p.x + row * 1024) + lane; f32x4 v[4], v2[4]; float s = 0.f, s2 = 0.f;
#pragma unroll
            for (int j = 0; j < 4; ++j) { v[j] = xr[64 * j]; v2[j] = xr[64 * j + 128 * 256]; }
#pragma unroll
            for (int j = 0; j < 4; ++j) { s += (v[j][0] * v[j][0] + v[j][1] * v[j][1]) + (v[j][2] * v[j][2] + v[j][3] * v[j][3]); s2 += (v2[j][0] * v2[j][0] + v2[j][1] * v2[j][1]) + (v2[j][2] * v2[j][2] + v2[j][3] * v2[j][3]); }
            const float rs = rsqrtf(wave_sum(s) * (1.f / 1024.f) + 1e-6f), rs2 = rsqrtf(wave_sum(s2) * (1.f / 1024.f) + 1e-6f);
            u32x2* o = (u32x2*)((bf16*)(p.ws + WS_H) + row * 1024) + lane;
#pragma unroll
            for (int j = 0; j < 4; ++j) { const f32x4 a = ((const f32x4*)A)[64 * j + lane], bb = ((const f32x4*)Bv)[64 * j + lane]; const f32x4 h = v[j] * rs * a + bb, h2 = v2[j] * rs2 * a + bb;
                u32x2 w; w.x = cvtpk(h[0], h[1]); w.y = cvtpk(h[2], h[3]); o[64 * j] = w; u32x2 w2; w2.x = cvtpk(h2[0], h2[1]); w2.y = cvtpk(h2[2], h2[3]); o[64 * j + 128 * 256] = w2; } }
    }
}
__device__ __forceinline__ void phase_mid(const Params& p, unsigned char* lds, int tid, int wave, int lane) {
    float* A1 = (float*)lds; float* A2 = A1 + 1024; float* A3 = A2 + 1024;
    const float* RSS = (const float*)(p.ws + WS_RSS1);
    for (int chunk = blockIdx.x; chunk < 256; chunk += gridDim.x) {
        const int b = chunk >> 5;
        __syncthreads();
        for (int col = tid; col < 1024; col += NTHREADS) { A1[col] = mod_val(p, b, 2048 + col) * p.g_post_mix[col]; A2[col] = p.g_pre_ffn[col] * (1.f + mod_val(p, b, 4096 + col)); A3[col] = mod_val(p, b, 3072 + col); }
        __syncthreads();
        for (int r = wave; r < 128; r += NWAVES) { const size_t row = (size_t)chunk * 256 + r; constexpr int D4 = 128 * 256;
            float ss = RSS[row * 16 + (lane & 15)], ssb = RSS[(row + 128) * 16 + (lane & 15)];
            const f32x4* xr = (const f32x4*)(p.x + row * 1024) + lane; const u32x2* yr = (const u32x2*)((const bf16*)(p.ws + WS_Y) + row * 1024) + lane;
            f32x4 v[4], vb[4]; u32x2 yw[4], ywb[4];
#pragma unroll
            for (int j = 0; j < 4; ++j) { v[j] = xr[64 * j]; vb[j] = xr[64 * j + D4]; yw[j] = yr[64 * j]; ywb[j] = yr[64 * j + D4]; }
            ss += __shfl_xor(ss, 1); ss += __shfl_xor(ss, 2); ss += __shfl_xor(ss, 4); ss += __shfl_xor(ss, 8);
            ssb += __shfl_xor(ssb, 1); ssb += __shfl_xor(ssb, 2); ssb += __shfl_xor(ssb, 4); ssb += __shfl_xor(ssb, 8);
            const float r1 = rsqrtf(ss * (1.f / 1024.f) + 1e-6f), r1b = rsqrtf(ssb * (1.f / 1024.f) + 1e-6f);
            f32x4* orow = (f32x4*)(p.out + row * 1024) + lane; float s = 0.f, sb = 0.f;
#pragma unroll
            for (int j = 0; j < 4; ++j) { const f32x4 a1 = ((const f32x4*)A1)[64 * j + lane];
                const f32x4 y = {bflo(yw[j].x), bfhi(yw[j].x), bflo(yw[j].y), bfhi(yw[j].y)}, yb = {bflo(ywb[j].x), bfhi(ywb[j].x), bflo(ywb[j].y), bfhi(ywb[j].y)};
                v[j] = v[j] + a1 * y * r1; vb[j] = vb[j] + a1 * yb * r1b; orow[64 * j] = v[j]; orow[64 * j + D4] = vb[j];
                s += (v[j][0] * v[j][0] + v[j][1] * v[j][1]) + (v[j][2] * v[j][2] + v[j][3] * v[j][3]); sb += (vb[j][0] * vb[j][0] + vb[j][1] * vb[j][1]) + (vb[j][2] * vb[j][2] + vb[j][3] * vb[j][3]); }
            const float r2 = rsqrtf(wave_sum(s) * (1.f / 1024.f) + 1e-6f), r2b = rsqrtf(wave_sum(sb) * (1.f / 1024.f) + 1e-6f);
            u32x2* o = (u32x2*)((bf16*)(p.ws + WS_H) + row * 1024) + lane;
#pragma unroll
            for (int j = 0; j < 4; ++j) { const f32x4 a = ((const f32x4*)A2)[64 * j + lane], bb = ((const f32x4*)A3)[64 * j + lane]; const f32x4 h = v[j] * r2 * a + bb, hb = vb[j] * r2b * a + bb;
                u32x2 w; w.x = cvtpk(h[0], h[1]); w.y = cvtpk(h[2], h[3]); o[64 * j] = w; u32x2 wb; wb.x = cvtpk(hb[0], hb[1]); wb.y = cvtpk(hb[2], hb[3]); o[64 * j + D4] = wb; } }
    }
}
__device__ __forceinline__ void phase_final(const Params& p, unsigned char* lds, int tid, int wave, int lane) {
    float* A1 = (float*)lds;
    const float* RSS = (const float*)(p.ws + WS_RSS2);
    for (int chunk = blockIdx.x; chunk < 256; chunk += gridDim.x) {
        const int b = chunk >> 5;
        __syncthreads();
        for (int col = tid; col < 1024; col += NTHREADS) A1[col] = mod_val(p, b, 5120 + col) * p.g_post_ffn[col];
        __syncthreads();
        for (int r = wave; r < 128; r += NWAVES) { const size_t row = (size_t)chunk * 256 + r; constexpr int D4 = 128 * 256;
            float ss = RSS[row * 16 + (lane & 15)], ssb = RSS[(row + 128) * 16 + (lane & 15)];
            const u32x2* yr = (const u32x2*)((const bf16*)(p.ws + WS_YCAT) + row * 1024) + lane; f32x4* orow = (f32x4*)(p.out + row * 1024) + lane;
            f32x4 v[4], vb[4]; u32x2 yw[4], ywb[4];
#pragma unroll
            for (int j = 0; j < 4; ++j) { v[j] = orow[64 * j]; vb[j] = orow[64 * j + D4]; yw[j] = yr[64 * j]; ywb[j] = yr[64 * j + D4]; }
            ss += __shfl_xor(ss, 1); ss += __shfl_xor(ss, 2); ss += __shfl_xor(ss, 4); ss += __shfl_xor(ss, 8);
            ssb += __shfl_xor(ssb, 1); ssb += __shfl_xor(ssb, 2); ssb += __shfl_xor(ssb, 4); ssb += __shfl_xor(ssb, 8);
            const float r1 = rsqrtf(ss * (1.f / 1024.f) + 1e-6f), r1b = rsqrtf(ssb * (1.f / 1024.f) + 1e-6f);
#pragma unroll
            for (int j = 0; j < 4; ++j) { const f32x4 a1 = ((const f32x4*)A1)[64 * j + lane];
                const f32x4 y = {bflo(yw[j].x), bfhi(yw[j].x), bflo(yw[j].y), bfhi(yw[j].y)}, yb = {bflo(ywb[j].x), bfhi(ywb[j].x), bflo(ywb[j].y), bfhi(ywb[j].y)};
                orow[64 * j] = v[j] + a1 * y * r1; orow[64 * j + D4] = vb[j] + a1 * yb * r1b; } }
    }
}

__device__ __forceinline__ float gelu_tanh(float x) { const float u = 0.7978845608f * (x + 0.044715f * x * x * x); const float e = __builtin_amdgcn_exp2f(2.885390082f * u); return 0.5f * x * (2.f - 2.f * __builtin_amdgcn_rcpf(1.f + e)); }
__device__ __forceinline__ void phase_cmp2_conv(const Params& p, unsigned char* lds, int gw, int NGW, int wave, int lane) {
    unsigned char* ws = p.ws;
    float* hs = (float*)(lds + wave * 1024);
    const bf16* HC = (const bf16*)(ws + WS_HC); const float* CBP = (const float*)(ws + WS_CBP);
    for (int it = gw; it < 16384; it += NGW) {
        const int kv = it >> 13, bg = (it >> 9) & 15, cc = it & 511; const size_t row = (size_t)it;
        float o = 0.f;
        if (cc < 511) {
            const float* w2 = kv ? p.w_cv2 : p.w_ck2;
#pragma unroll
            for (int hh = 0; hh < 2; ++hh) { const int n = lane + 64 * hh; float bsum = 0.f;
#pragma unroll
                for (int kc = 0; kc < 16; ++kc) bsum += CBP[(kv * 16 + kc) * 128 + n];
                const float pre = bflo((unsigned)HC[row * 256 + n]) + bflo((unsigned)HC[(row + 1) * 256 + 128 + n]) + bsum;
                hs[n] = gelu_tanh(pre); }
            LDS_WAIT();
#pragma unroll 8
            for (int n = 0; n < 128; ++n) o += hs[n] * w2[n * 64 + lane];
            LDS_WAIT();
        }
        const bf16 ob = (bf16)(cvtpk(o, 0.f) & 0xffffu);
        if (kv == 0) ((bf16*)(ws + WS_KCC))[((size_t)bg * 512 + cc) * 64 + lane] = ob;
        else ((bf16*)(ws + WS_VCT))[((size_t)bg * 64 + lane) * 512 + cc] = ob;
    }
    const bf16* U = (const bf16*)(ws + WS_U); bf16* YC = (bf16*)(ws + WS_YCAT);
    float cw[3][8], gco[8];
#pragma unroll
    for (int w = 0; w < 3; ++w)
#pragma unroll
        for (int e = 0; e < 8; ++e) cw[w][e] = p.conv_w[w * 512 + 8 * lane + e];
#pragma unroll
    for (int e = 0; e < 8; ++e) gco[e] = p.g_conv_out[8 * lane + e];
    for (int it = gw; it < MTOK / 32; it += NGW) {
        const int t0 = it * 32; float z1[8], z2[8];
#pragma unroll
        for (int e = 0; e < 8; ++e) { z1[e] = 0.f; z2[e] = 0.f; }
        if ((t0 & (SEQ - 1)) != 0) {
#pragma unroll
            for (int bk = 1; bk <= 2; ++bk) { const bf16* ur = U + (size_t)(t0 - bk) * 2048 + 8 * lane; const u32x4 cg_ = *(const u32x4*)(ur + 512), vv = *(const u32x4*)(ur + 1024);
                float* z = bk == 1 ? z1 : z2;
                z[0] = bflo(cg_.x) * bflo(vv.x); z[1] = bfhi(cg_.x) * bfhi(vv.x); z[2] = bflo(cg_.y) * bflo(vv.y); z[3] = bfhi(cg_.y) * bfhi(vv.y);
                z[4] = bflo(cg_.z) * bflo(vv.z); z[5] = bfhi(cg_.z) * bfhi(vv.z); z[6] = bflo(cg_.w) * bflo(vv.w); z[7] = bfhi(cg_.w) * bfhi(vv.w); }
        }
        for (int tt = 0; tt < 32; ++tt) { const bf16* ur = U + (size_t)(t0 + tt) * 2048 + 8 * lane;
            const u32x4 bg_ = *(const u32x4*)ur, cg_ = *(const u32x4*)(ur + 512), vv = *(const u32x4*)(ur + 1024); float z0[8], bgf[8], y[8];
            z0[0] = bflo(cg_.x) * bflo(vv.x); z0[1] = bfhi(cg_.x) * bfhi(vv.x); z0[2] = bflo(cg_.y) * bflo(vv.y); z0[3] = bfhi(cg_.y) * bfhi(vv.y);
            z0[4] = bflo(cg_.z) * bflo(vv.z); z0[5] = bfhi(cg_.z) * bfhi(vv.z); z0[6] = bflo(cg_.w) * bflo(vv.w); z0[7] = bfhi(cg_.w) * bfhi(vv.w);
            bgf[0] = bflo(bg_.x); bgf[1] = bfhi(bg_.x); bgf[2] = bflo(bg_.y); bgf[3] = bfhi(bg_.y); bgf[4] = bflo(bg_.z); bgf[5] = bfhi(bg_.z); bgf[6] = bflo(bg_.w); bgf[7] = bfhi(bg_.w);
            float s = 0.f;
#pragma unroll
            for (int e = 0; e < 8; ++e) { y[e] = bgf[e] * (cw[0][e] * z2[e] + cw[1][e] * z1[e] + cw[2][e] * z0[e]); s += y[e] * y[e]; z2[e] = z1[e]; z1[e] = z0[e]; }
            const float rs = rsqrtf(wave_sum(s) * (1.f / 512.f) + 1e-6f);
            u32x4 o; o.x = cvtpk(y[0] * rs * gco[0], y[1] * rs * gco[1]); o.y = cvtpk(y[2] * rs * gco[2], y[3] * rs * gco[3]); o.z = cvtpk(y[4] * rs * gco[4], y[5] * rs * gco[5]); o.w = cvtpk(y[6] * rs * gco[6], y[7] * rs * gco[7]);
            *(u32x4*)(YC + (size_t)(t0 + tt) * 1024 + 8 * lane) = o; }
    }
}

#define MFMA16(a, b, c) __builtin_amdgcn_mfma_f32_16x16x32_bf16((a), (b), (c), 0, 0, 0)
constexpr float CEXP = 0.18033688011f;
constexpr float NEGB = -1e30f;

template <int MODE>
__device__ __forceinline__ void attn_unit(const char* Kp  , unsigned voffK, const char* VTp  , unsigned vstep  , unsigned voffV,
                                          const float (&base)[2][4], const float (&sl8)[4],
                                          const bf16x8* QS, f32x4 (&O)[4][4], float (&m)[4], float (&l)[4], const float (&linv)[4], float (&psum)[2][4]) {
    bf16x8 kf[2][2], vf[4];
#pragma unroll
    for (int od = 0; od < 2; ++od)
#pragma unroll
        for (int ks = 0; ks < 2; ++ks) kf[od][ks] = *(const bf16x8*)(Kp + voffK + (od * 512 + ks * 64));
    if (MODE != 0) {
#pragma unroll
        for (int ds = 0; ds < 4; ++ds) vf[ds] = *(const bf16x8*)(VTp + (size_t)ds * vstep + voffV);
    }
    if (MODE == 1) {
#pragma unroll
        for (int od = 0; od < 2; ++od)
#pragma unroll
            for (int i = 0; i < 4; ++i) psum[od][i] = 0.f;
    }
#pragma unroll
    for (int h = 0; h < 4; ++h) {
        f32x4 a0, a1;
#pragma unroll
        for (int i = 0; i < 4; ++i) { a0[i] = base[0][i] * sl8[h]; a1[i] = base[1][i] * sl8[h]; }
#pragma unroll
        for (int ks = 0; ks < 2; ++ks) { const bf16x8 qv = QS[(h * 2 + ks) * 64]; a0 = MFMA16(kf[0][ks], qv, a0); a1 = MFMA16(kf[1][ks], qv, a1); }
        float p0[4], p1[4];
        if (MODE == 1) {
#pragma unroll
            for (int i = 0; i < 4; ++i) { p0[i] = __builtin_amdgcn_exp2f((a0[i] - m[h]) * CEXP) * linv[h]; p1[i] = __builtin_amdgcn_exp2f((a1[i] - m[h]) * CEXP) * linv[h]; psum[0][i] += p0[i]; psum[1][i] += p1[i]; }
        } else {
            float tm = fmaxf(fmaxf(fmaxf(a0[0], a0[1]), fmaxf(a0[2], a0[3])), fmaxf(fmaxf(a1[0], a1[1]), fmaxf(a1[2], a1[3])));
            tm = fmaxf(tm, __shfl_xor(tm, 16)); tm = fmaxf(tm, __shfl_xor(tm, 32));
            const float mn = fmaxf(m[h], tm), alpha = __builtin_amdgcn_exp2f((m[h] - mn) * CEXP); m[h] = mn;
            float ps = 0.f;
#pragma unroll
            for (int i = 0; i < 4; ++i) { p0[i] = __builtin_amdgcn_exp2f((a0[i] - mn) * CEXP); p1[i] = __builtin_amdgcn_exp2f((a1[i] - mn) * CEXP); ps += p0[i] + p1[i]; }
            l[h] = l[h] * alpha + ps;
            if (MODE == 2) {
#pragma unroll
                for (int ds = 0; ds < 4; ++ds) O[h][ds] = O[h][ds] * alpha;
            }
        }
        if (MODE != 0) {
            u32x4 pw; pw.x = cvtpk(p0[0], p0[1]); pw.y = cvtpk(p0[2], p0[3]); pw.z = cvtpk(p1[0], p1[1]); pw.w = cvtpk(p1[2], p1[3]);
            const bf16x8 pf = __builtin_bit_cast(bf16x8, pw);
#pragma unroll
            for (int ds = 0; ds < 4; ++ds) O[h][ds] = MFMA16(vf[ds], pf, O[h][ds]);
        }
    }
}

__device__ __forceinline__ void phase_attn(const Params& p, unsigned char* lds, int gw, int NGW, int wave, int lane) {
    unsigned char* ws = p.ws;
    const bf16* U = (const bf16*)(ws + WS_U); const float* GATES = (const float*)(ws + WS_GATES);
    const bf16* KCC = (const bf16*)(ws + WS_KCC); const bf16* VCT = (const bf16*)(ws + WS_VCT);
    const bf16* KS = (const bf16*)(ws + WS_KS); const bf16* KW = (const bf16*)(ws + WS_KW); const bf16* VST = (const bf16*)(ws + WS_VST); const bf16* VWT = (const bf16*)(ws + WS_VWT);
    bf16* YC = (bf16*)(ws + WS_YCAT);
    bf16x8* QSW = (bf16x8*)(lds + wave * 16640);
    const bf16x8* QS = QSW + lane;
    float* IMP = (float*)(lds + wave * 16640 + 8192);
    f32x4* FW = (f32x4*)(ws + WS_FSCR) + (size_t)gw * 1024 + lane * 16;
    const int qi = lane & 15, g4 = lane >> 4;
    const unsigned voffK = (unsigned)((8 * (qi >> 2) + (qi & 3)) * 128 + 16 * g4), voffV = (unsigned)(qi * SEQ * 2 + 16 * g4), voffVc = (unsigned)(qi * 512 * 2 + 16 * g4);
    for (int item = gw; item < 8192; item += NGW) {
        const int bi = item >> 3, bg = bi & 15, qt = (63 - (bi >> 4)) * 8 + (item & 7), g = bg & 1, b = bg >> 1;
        const int q0 = qt * 16, t = q0 + qi, cur = q0 >> 6;
        const size_t tokrow = (size_t)b * SEQ + t;
        float sl8[4];
#pragma unroll
        for (int h = 0; h < 4; ++h) { sl8[h] = 8.f * __builtin_amdgcn_exp2f(-(float)(g * 4 + h + 1));
#pragma unroll
            for (int ks = 0; ks < 2; ++ks) QSW[(h * 2 + ks) * 64 + lane] = *(const bf16x8*)(U + tokrow * 2048 + 1536 + (g * 4 + h) * 64 + 32 * ks + 8 * g4); }
        f32x4 O[4][4]; float m[4], l[4], linv[4], psum[2][4], base[2][4];
#pragma unroll
        for (int k = 0; k < 33; ++k) { const int idx = lane + 64 * k; if (idx < 16 * 129) IMP[idx] = 0.f; }
#pragma unroll
        for (int h = 0; h < 4; ++h) { m[h] = -1e20f; l[h] = 0.f; linv[h] = 0.f;
#pragma unroll
            for (int ds = 0; ds < 4; ++ds) O[h][ds] = (f32x4){0.f, 0.f, 0.f, 0.f}; }
        const int nun = (qt + 31) >> 5;
        const int cimax = (t - 31) >> 4;
        const char* Kc = (const char*)(KCC + (size_t)bg * 512 * 64); const char* Vc = (const char*)(VCT + (size_t)bg * 64 * 512);
#pragma unroll 1
        for (int u = 0; u < nun; ++u) { const int kb = 32 * u;
#pragma unroll
            for (int od = 0; od < 2; ++od)
#pragma unroll
                for (int i = 0; i < 4; ++i) { const int ci = kb + 8 * g4 + 4 * od + i; base[od][i] = ci <= cimax ? (float)(16 * ci - q0) : NEGB; }
            attn_unit<0>(Kc + (size_t)kb * 128, voffK, nullptr, 0u, 0u, base, sl8, QS, O, m, l, linv, psum); }
#pragma unroll
        for (int h = 0; h < 4; ++h) { float lt = l[h]; lt += __shfl_xor(lt, 16); lt += __shfl_xor(lt, 32); linv[h] = lt > 0.f ? 1.f / lt : 0.f; }
#pragma unroll 1
        for (int u = 0; u < nun; ++u) { const int kb = 32 * u;
#pragma unroll
            for (int od = 0; od < 2; ++od)
#pragma unroll
                for (int i = 0; i < 4; ++i) { const int ci = kb + 8 * g4 + 4 * od + i; base[od][i] = ci <= cimax ? (float)(16 * ci - q0) : NEGB; }
            attn_unit<1>(Kc + (size_t)kb * 128, voffK, Vc + (size_t)kb * 2, 16u * 512u * 2u, voffVc, base, sl8, QS, O, m, l, linv, psum);
#pragma unroll
            for (int od = 0; od < 2; ++od) { const int jb = (kb >> 2) + 2 * g4 + od;
                atomicAdd(&IMP[qi * 129 + jb], (psum[od][0] + psum[od][1]) + (psum[od][2] + psum[od][3]));
                atomicAdd(&IMP[qi * 129 + jb + 1], psum[od][3]); } }
#pragma unroll
        for (int h = 0; h < 4; ++h)
#pragma unroll
            for (int ds = 0; ds < 4; ++ds) FW[h * 4 + ds] = O[h][ds] * GATES[tokrow * 24 + (g * 4 + h) * 3 + 0];
        LDS_WAIT();
        unsigned sel[4];
        if (cur >= 16) {
            unsigned key[32];
#pragma unroll
            for (int e = 0; e < 32; ++e) { const int jb = 32 * g4 + e; const float v = IMP[qi * 129 + jb]; key[e] = (jb >= 1 && jb <= cur - 2) ? ((__float_as_uint(v) & 0xFFFFFF80u) | (unsigned)(127 - jb)) : 0u; }
            unsigned mymask = 0u;
#pragma unroll 1
            for (int r = 0; r < 13; ++r) {
                unsigned mk = 0u;
#pragma unroll
                for (int e = 0; e < 32; ++e) mk = key[e] > mk ? key[e] : mk;
                unsigned o1 = (unsigned)__shfl_xor((int)mk, 16); mk = o1 > mk ? o1 : mk; o1 = (unsigned)__shfl_xor((int)mk, 32); mk = o1 > mk ? o1 : mk;
                const int jw = 127 - (int)(mk & 127u);
                if ((jw >> 5) == g4) mymask |= 1u << (jw & 31);
#pragma unroll
                for (int e = 0; e < 32; ++e) key[e] = key[e] == mk ? 0u : key[e];
            }
#pragma unroll
            for (int gg = 0; gg < 4; ++gg) { unsigned s = (unsigned)__shfl((int)mymask, 16 * gg + qi);
                if (gg == 0) s |= 1u;
                if (((cur - 1) >> 5) == gg) s |= 1u << ((cur - 1) & 31);
                if ((cur >> 5) == gg) s |= 1u << (cur & 31);
                sel[gg] = s; }
        } else { sel[0] = (2u << cur) - 1u; sel[1] = 0u; sel[2] = 0u; sel[3] = 0u; }
        unsigned un[4];
#pragma unroll
        for (int gg = 0; gg < 4; ++gg) { unsigned v = sel[gg]; v |= (unsigned)__shfl_xor((int)v, 1); v |= (unsigned)__shfl_xor((int)v, 2); v |= (unsigned)__shfl_xor((int)v, 4); v |= (unsigned)__shfl_xor((int)v, 8);
            un[gg] = (unsigned)__builtin_amdgcn_readfirstlane((int)v); }
#pragma unroll
        for (int h = 0; h < 4; ++h) { m[h] = -1e20f; l[h] = 0.f;
#pragma unroll
            for (int ds = 0; ds < 4; ++ds) O[h][ds] = (f32x4){0.f, 0.f, 0.f, 0.f}; }
        {
            const char* Kb = (const char*)(KS + (size_t)bg * SEQ * 64); const char* Vb = (const char*)(VST + (size_t)bg * 64 * SEQ);
#pragma unroll
            for (int gg = 0; gg < 4; ++gg) { unsigned um = un[gg];
                while (um) { const int bit = __builtin_ctz(um); um &= um - 1u; const int jb = 32 * gg + bit; const bool selq = (sel[gg] >> bit) & 1u;
#pragma unroll 1
                    for (int hf = 0; hf < 2; ++hf) { const int kb = 64 * jb + 32 * hf;
#pragma unroll
                        for (int od = 0; od < 2; ++od)
#pragma unroll
                            for (int i = 0; i < 4; ++i) { const int kpos = kb + 8 * g4 + 4 * od + i; base[od][i] = (selq && kpos <= t) ? (float)(kpos - q0) : NEGB; }
                        attn_unit<2>(Kb + (size_t)kb * 128, voffK, Vb + (size_t)kb * 2, 16u * SEQ * 2u, voffV, base, sl8, QS, O, m, l, linv, psum); } } }
        }
#pragma unroll
        for (int h = 0; h < 4; ++h) { float lt = l[h]; lt += __shfl_xor(lt, 16); lt += __shfl_xor(lt, 32); const float f = lt > 0.f ? GATES[tokrow * 24 + (g * 4 + h) * 3 + 1] / lt : 0.f;
#pragma unroll
            for (int ds = 0; ds < 4; ++ds) FW[h * 4 + ds] = FW[h * 4 + ds] + O[h][ds] * f; }
#pragma unroll
        for (int h = 0; h < 4; ++h) { m[h] = -1e20f; l[h] = 0.f;
#pragma unroll
            for (int ds = 0; ds < 4; ++ds) O[h][ds] = (f32x4){0.f, 0.f, 0.f, 0.f}; }
        {
            const char* Kb = (const char*)(KW + (size_t)bg * SEQ * 64); const char* Vb = (const char*)(VWT + (size_t)bg * 64 * SEQ);
            const int kb0 = q0 >= 511 ? ((q0 - 511) & ~31) : 0;
#pragma unroll 1
            for (int kb = kb0; kb <= q0 + 15; kb += 32) {
#pragma unroll
                for (int od = 0; od < 2; ++od)
#pragma unroll
                    for (int i = 0; i < 4; ++i) { const int kpos = kb + 8 * g4 + 4 * od + i, dd = t - kpos; base[od][i] = (dd >= 0 && dd < 512) ? (float)(kpos - q0) : NEGB; }
                attn_unit<2>(Kb + (size_t)kb * 128, voffK, Vb + (size_t)kb * 2, 16u * SEQ * 2u, voffV, base, sl8, QS, O, m, l, linv, psum); }
        }
#pragma unroll
        for (int h = 0; h < 4; ++h) { float lt = l[h]; lt += __shfl_xor(lt, 16); lt += __shfl_xor(lt, 32); const float f = lt > 0.f ? GATES[tokrow * 24 + (g * 4 + h) * 3 + 2] / lt : 0.f; float ss = 0.f;
#pragma unroll
            for (int ds = 0; ds < 4; ++ds) { O[h][ds] = FW[h * 4 + ds] + O[h][ds] * f; ss += (O[h][ds][0] * O[h][ds][0] + O[h][ds][1] * O[h][ds][1]) + (O[h][ds][2] * O[h][ds][2] + O[h][ds][3] * O[h][ds][3]); }
            ss += __shfl_xor(ss, 16); ss += __shfl_xor(ss, 32);
            const float rs = rsqrtf(ss * (1.f / 64.f) + 1e-6f);
#pragma unroll
            for (int ds = 0; ds < 4; ++ds) { const int dcol = (g * 4 + h) * 64 + 16 * ds + 4 * g4; const f32x4 gg_ = *(const f32x4*)(p.g_attn_out + dcol); const f32x4 y = O[h][ds] * rs * gg_;
                u32x2 w; w.x = cvtpk(y[0], y[1]); w.y = cvtpk(y[2], y[3]); *(u32x2*)(YC + tokrow * 1024 + 512 + dcol) = w; } }
        LDS_WAIT();
    }
}


#define LAS __attribute__((address_space(3)))
#define XB_TMO      128
#define XB_XCNT(j)  (256  + 64 * (j))
#define XB_XSUB(j)  (1280 + 64 * (j))
#define XB_XGEN(j)  (2304 + 64 * (j))
#define XB_TOP      3328
#define XB_TOPGEN   3392
#define XCD_BAR_WORDS 3456
#define XB_SPIN_CAP (1u << 18)

__device__ __forceinline__ unsigned xb_ld(unsigned* p)              { return __hip_atomic_load(p, __ATOMIC_RELAXED, __HIP_MEMORY_SCOPE_AGENT); }
__device__ __forceinline__ unsigned xb_add(unsigned* p, unsigned v) { return __hip_atomic_fetch_add(p, v, __ATOMIC_RELAXED, __HIP_MEMORY_SCOPE_AGENT); }
__device__ __forceinline__ unsigned xb_xcc_id() { return (unsigned)__builtin_amdgcn_s_getreg((3 << 11) | 20) & 0xFu; }
#define XB_SPIN(cond, bar) do { unsigned _sp = 0; while (cond) { __builtin_amdgcn_s_sleep(1); \
    if ((++_sp & 255u) == 0u) { if (xb_ld(&(bar)[XB_TMO])) break; if (_sp > XB_SPIN_CAP) { atomicAdd(&(bar)[XB_TMO], 1u); break; } } } } while (0)

struct XcdBarrier {
    unsigned* bar; unsigned x;
    volatile LAS unsigned* st;
};

__device__ __forceinline__ XcdBarrier xcd_barrier_post(unsigned* bar, volatile LAS unsigned* st) {
    XcdBarrier b; b.bar = bar; b.x = xb_xcc_id(); b.st = st;
    if (threadIdx.x == 0) (void)xb_add(&bar[XB_XCNT(b.x)], 1u);
    return b;
}
__device__ __forceinline__ void xcd_barrier_complete(unsigned* bar, unsigned x, unsigned& nloc, unsigned& nx) {
    const unsigned G = gridDim.x * gridDim.y * gridDim.z;
    unsigned sum, cnt, mine, sp = 0u;
    for (;;) {
        sum = 0u; cnt = 0u; mine = 0u;
#pragma unroll
        for (unsigned j = 0; j < 16; ++j) { const unsigned c = xb_ld(&bar[XB_XCNT(j)]); sum += c; cnt += (c > 0u) ? 1u : 0u; mine = (j == x) ? c : mine; }
        if (sum == G) break;
        __builtin_amdgcn_s_sleep(1);
        if ((++sp & 255u) == 0u) { if (xb_ld(&bar[XB_TMO])) break; if (sp > XB_SPIN_CAP) { atomicAdd(&bar[XB_TMO], 1u); break; } }
    }
    nloc = mine > 0u ? mine : 1u; nx = cnt > 0u ? cnt : 1u;
}

__device__ __forceinline__ void xcd_barrier(const XcdBarrier& b) {
    asm volatile("s_waitcnt vmcnt(0)" ::: "memory");
    __syncthreads();
    if (threadIdx.x == 0) {
        unsigned* bar = b.bar;
        __builtin_amdgcn_s_waitcnt(0);
        unsigned nloc = b.st[0], nx = b.st[1];
        if (nloc == 0u) { xcd_barrier_complete(bar, b.x, nloc, nx); b.st[0] = nloc; b.st[1] = nx; }
        const unsigned old = xb_add(&bar[XB_XSUB(b.x)], 1u);
        const unsigned gen = old / nloc;
        if (old + 1u == (gen + 1u) * nloc) {
            __builtin_amdgcn_fence(__ATOMIC_RELEASE, "agent");
            asm volatile("s_waitcnt vmcnt(0)" ::: "memory");
            const unsigned og = xb_add(&bar[XB_TOP], 1u);
            const unsigned tg = og / nx;
            if (og + 1u == (tg + 1u) * nx) xb_add(&bar[XB_TOPGEN], 1u);
            else XB_SPIN(xb_ld(&bar[XB_TOPGEN]) == tg, bar);
            __builtin_amdgcn_fence(__ATOMIC_ACQUIRE, "agent");
            xb_add(&bar[XB_XGEN(b.x)], 1u);
            asm volatile("s_waitcnt vmcnt(0)" ::: "memory");
        } else {
            XB_SPIN(xb_ld(&bar[XB_XGEN(b.x)]) == gen, bar);
            __builtin_amdgcn_fence(__ATOMIC_ACQUIRE, "agent");
            asm volatile("s_waitcnt vmcnt(0)" ::: "memory");
        }
    }
    __syncthreads();
}

__global__ void __launch_bounds__(NTHREADS, 2) fwd_kernel(Params p) {
    extern __shared__ __attribute__((aligned(16))) unsigned char lds[];
    cg::grid_group grid = cg::this_grid();
    const int wave = __builtin_amdgcn_readfirstlane(threadIdx.x >> 6);
    const int G = gridDim.x, gw = blockIdx.x * NWAVES + wave, NGW = G * NWAVES;
    PG8_LAS unsigned char* ldsl = (PG8_LAS unsigned char*)lds;
    unsigned char* ws = p.ws;

    volatile LAS unsigned* bst = (volatile LAS unsigned*)((LAS unsigned char*)lds + (LDS_BYTES - 64));
    if (threadIdx.x < 2) bst[threadIdx.x] = 0u;
    __syncthreads();
    const XcdBarrier bar = xcd_barrier_post((unsigned*)(ws + WS_CTL), bst);
    phase0(p, lds, gw, NGW, wave, pg8::fresh_lane());
    grid.sync();
    { const int ln = pg8::fresh_lane(); phase_norm1(p, lds, wave * 64 + ln, wave, ln); }
    xcd_barrier(bar);
    {
        pg8::Gemm g{(const pg8::bf16_t*)(ws + WS_H), (const pg8::bf16_t*)(ws + WS_WIN), MTOK, NINP, 1024};
        pg8::StaticOrder S; S.init(MTOK, NINP, G, (int)blockIdx.x);
        pg8::EpiIn E{(pg8::bf16_t*)(ws + WS_U), (pg8::bf16_t*)(ws + WS_KC), (pg8::bf16_t*)(ws + WS_KS), (pg8::bf16_t*)(ws + WS_KW), (pg8::bf16_t*)(ws + WS_VST), (pg8::bf16_t*)(ws + WS_VWT), (float*)(ws + WS_GATES)};
        pg8::gemm_phase<pg8::EpiIn, pg8::StaticOrder, true, true>(ldsl, g, S, E, wave);
    }
    xcd_barrier(bar);
    {
        pg8::Gemm gk{(const pg8::bf16_t*)(ws + WS_KC), (const pg8::bf16_t*)(ws + WS_W1K), 8192, 256, 1024};
        pg8::StaticOrder S; S.init(8192, 256, G, (int)blockIdx.x);
        pg8::EpiPlain E{(pg8::bf16_t*)(ws + WS_HC), 256};
        pg8::gemm_phase<pg8::EpiPlain, pg8::StaticOrder, true, true>(ldsl, gk, S, E, wave);
        pg8::Gemm gv{(const pg8::bf16_t*)(ws + WS_KC) + (size_t)8192 * 1024, (const pg8::bf16_t*)(ws + WS_W1V), 8192, 256, 1024};
        pg8::StaticOrder S2; S2.init(8192, 256, G, (int)((blockIdx.x + G - 32) % G));
        pg8::EpiPlain E2{(pg8::bf16_t*)(ws + WS_HC) + (size_t)8192 * 256, 256};
        pg8::gemm_phase<pg8::EpiPlain, pg8::StaticOrder, true, true>(ldsl, gv, S2, E2, wave);
    }
    xcd_barrier(bar);
    phase_cmp2_conv(p, lds, gw, NGW, wave, pg8::fresh_lane());
    xcd_barrier(bar);
#ifndef NO_ATTN
    phase_attn(p, lds, gw, NGW, wave, pg8::fresh_lane());
#endif
    xcd_barrier(bar);
    {
        pg8::Gemm g{(const pg8::bf16_t*)(ws + WS_YCAT), (const pg8::bf16_t*)(ws + WS_WOUT), MTOK, 1024, 1024};
        pg8::StaticOrder S; S.init(MTOK, 1024, G, (int)blockIdx.x);
        pg8::EpiRow E{(pg8::bf16_t*)(ws + WS_Y), (float*)(ws + WS_RSS1)};
        pg8::gemm_phase<pg8::EpiRow, pg8::StaticOrder, true, true>(ldsl, g, S, E, wave);
    }
    xcd_barrier(bar);
    { const int ln = pg8::fresh_lane(); phase_mid(p, lds, wave * 64 + ln, wave, ln); }
    xcd_barrier(bar);
    {
        pg8::Gemm g{(const pg8::bf16_t*)(ws + WS_H), (const pg8::bf16_t*)(ws + WS_WGU), MTOK, 2 * DFF, 1024};
        pg8::StaticOrder S; S.init(MTOK, 2 * DFF, G, (int)blockIdx.x);
        pg8::EpiGU E{(pg8::bf16_t*)(ws + WS_ACT)};
        pg8::gemm_phase<pg8::EpiGU, pg8::StaticOrder, true, true>(ldsl, g, S, E, wave);
    }
    xcd_barrier(bar);
    {
        pg8::Gemm g{(const pg8::bf16_t*)(ws + WS_ACT), (const pg8::bf16_t*)(ws + WS_WDN), MTOK, 1024, DFF};
        pg8::StaticOrder S; S.init(MTOK, 1024, G, (int)blockIdx.x);
        pg8::EpiRow E{(pg8::bf16_t*)(ws + WS_YCAT), (float*)(ws + WS_RSS2)};
        pg8::gemm_phase<pg8::EpiRow, pg8::StaticOrder, true, true>(ldsl, g, S, E, wave);
    }
    xcd_barrier(bar);
    { const int ln = pg8::fresh_lane(); phase_final(p, lds, wave * 64 + ln, wave, ln); }
}

extern "C" void kernel_launch(void* const* d_in, const int* in_sizes, int n_in, void* d_out, int out_size, void* d_ws, size_t ws_size, hipStream_t stream) {
    static int grid = 0;
    if (grid == 0) {
        if (n_in != 21 || ws_size < WS_END) { fprintf(stderr, "kernel_launch: unexpected n_in %d / ws %zu\n", n_in, ws_size); grid = -1; return; }
        int dev = 0, cus = 0, per_cu = 0;
        hipGetDevice(&dev); hipDeviceGetAttribute(&cus, hipDeviceAttributeMultiprocessorCount, dev);
        if (hipFuncSetAttribute((const void*)fwd_kernel, hipFuncAttributeMaxDynamicSharedMemorySize, LDS_BYTES) != hipSuccess) { fprintf(stderr, "kernel_launch: hipFuncSetAttribute failed\n"); grid = -1; return; }
        if (hipOccupancyMaxActiveBlocksPerMultiprocessor(&per_cu, (const void*)fwd_kernel, NTHREADS, LDS_BYTES) != hipSuccess || per_cu < 1) { fprintf(stderr, "kernel_launch: occupancy query says %d\n", per_cu); per_cu = 1; }
        (void)hipGetLastError();
        grid = cus * 1;
    }
    if (grid < 0) return;
    if (hipMemsetAsync((char*)d_ws + WS_CTL, 0, 16384, stream) != hipSuccess) { fprintf(stderr, "kernel_launch: memset failed\n"); return; }
    Params p{};
    const float** pp = (const float**)&p;
    for (int i = 0; i < 21; ++i) pp[i] = (const float*)d_in[i];
    p.out = (float*)d_out; p.ws = (unsigned char*)d_ws;
    void* args[] = {&p};
    hipError_t e = hipLaunchCooperativeKernel((const void*)fwd_kernel, dim3(grid), dim3(NTHREADS), args, LDS_BYTES, stream);
    if (e != hipSuccess) fprintf(stderr, "cooperative launch failed: %s (grid %d)\n", hipGetErrorString(e), grid);
}
```
